# Optimizing an MI355X kernel written in HIP

```python
import math
import jax, jax.numpy as jnp
from jax import lax
import numpy as np

D_MODEL = 1024
BATCH = 2
SEQ = 8192
DEPTH = 2

CTX_LEN = 256
GRID_W = 64
N_MIXERS = 2
EPS = 1e-6

FN_EXPAND = 2
FN_WIDTH = FN_EXPAND * D_MODEL
FN_GROUPS = 8
FN_GROUP_DIM = FN_WIDTH // FN_GROUPS

DN_HEADS = 8
DN_DK = 128
DN_DV = 256
DN_QK_WIDTH = DN_HEADS * DN_DK
DN_V_WIDTH = DN_HEADS * DN_DV
DN_QKV_WIDTH = 2 * DN_QK_WIDTH + DN_V_WIDTH
DN_PROJ_WIDTH = DN_QKV_WIDTH + DN_V_WIDTH + 4 * DN_HEADS
DN_CONV = 3
DN_CHUNK = 64

N_FOURIER_LAYERS = (DEPTH + 1) // 2
N_DELTA_LAYERS = DEPTH // 2

kernel_name = "hybrid_fourier_gdn_prefix_backbone"


def rmsnorm(x, g):
    xf = x.astype(jnp.float32)
    y = xf * lax.rsqrt(jnp.mean(xf * xf, axis=-1, keepdims=True) + EPS)
    return (y * g.astype(jnp.float32)).astype(x.dtype)


def l2norm(x):
    return x * lax.rsqrt(jnp.sum(x * x, axis=-1, keepdims=True) + EPS)


def adaln(cond, w, b):
    m = jax.nn.silu(cond) @ w + b
    return jnp.split(m, 3, axis=-1)


def fourier_mix(h, w_in, w_grp, w_out):
    u, z = jnp.split(h @ w_in, 2, axis=-1)
    b_, l_ = u.shape[:2]
    u = u.reshape(b_, l_, FN_GROUPS, FN_GROUP_DIM).astype(jnp.float32)
    f = jnp.real(jnp.fft.fft2(u, axes=(1, 3), norm="ortho")).astype(h.dtype)
    f = jnp.einsum("blgc,gcd->blgd", f, w_grp).reshape(b_, l_, FN_WIDTH)
    return (f * jax.nn.silu(z)) @ w_out


def short_conv_silu(u, w, rows, cols):
    b_, l_, ch = u.shape
    y = lax.conv_general_dilated(
        u.reshape(b_, rows, cols, ch), w[:, :, None, :].astype(u.dtype),
        window_strides=(1, 1), padding="SAME",
        dimension_numbers=("NHWC", "HWIO", "NHWC"), feature_group_count=ch)
    return jax.nn.silu(y.reshape(b_, l_, ch))


def gated_delta_chunked(q, k, v, g, beta, s0, with_output):
    b_, h_, l_, dk = q.shape
    dv = v.shape[-1]
    c_ = DN_CHUNK
    n_ = l_ // c_
    q = q.reshape(b_, h_, n_, c_, dk)
    k = k.reshape(b_, h_, n_, c_, dk)
    v = v.reshape(b_, h_, n_, c_, dv)
    g = jnp.cumsum(g.reshape(b_, h_, n_, c_), axis=-1)
    beta = beta.reshape(b_, h_, n_, c_)
    lower = jnp.tril(jnp.ones((c_, c_), dtype=bool))
    strict = jnp.tril(jnp.ones((c_, c_), dtype=bool), -1)
    diff = g[..., :, None] - g[..., None, :]
    decay = jnp.where(lower, jnp.exp(jnp.where(lower, diff, 0.0)), 0.0)
    kb = k * beta[..., None]
    kk = jnp.einsum("bhnid,bhnjd->bhnij", kb, k)
    a_mat = jnp.eye(c_, dtype=q.dtype) + jnp.where(strict, kk * decay, 0.0)
    rhs = jnp.concatenate([v * beta[..., None], kb * jnp.exp(g)[..., None]], axis=-1)
    sol = lax.linalg.triangular_solve(a_mat, rhs, left_side=True, lower=True, unit_diagonal=True)
    u, w = sol[..., :dv], sol[..., dv:]
    g_last = g[..., -1]
    k_tail = k * jnp.exp(g_last[..., None] - g)[..., None]
    to_scan = lambda t: jnp.moveaxis(t, 2, 0)
    if with_output:
        qk = jnp.einsum("bhnid,bhnjd->bhnij", q, k) * decay
        q_head = q * jnp.exp(g)[..., None]
        xs = tuple(map(to_scan, (u, w, k_tail, g_last, q_head, qk)))
    else:
        xs = tuple(map(to_scan, (u, w, k_tail, g_last)))

    def step(state, xs_c):
        u_c, w_c, kt_c, gl_c = xs_c[:4]
        v_new = u_c - jnp.einsum("bhcd,bhde->bhce", w_c, state)
        s_next = state * jnp.exp(gl_c)[..., None, None] + jnp.einsum("bhcd,bhce->bhde", kt_c, v_new)
        if with_output:
            qh_c, qk_c = xs_c[4:]
            o = jnp.einsum("bhcd,bhde->bhce", qh_c, state) + jnp.einsum("bhij,bhje->bhie", qk_c, v_new)
            return s_next, o
        return s_next, None

    s_final, o = lax.scan(step, s0, xs)
    if with_output:
        o = jnp.moveaxis(o, 0, 2).reshape(b_, h_, l_, dv)
    return o, s_final


def delta_project(h, w_in, conv_w, a_log, dt_bias, rows, cols):
    b_, l_, _ = h.shape
    p = h @ w_in
    qkv, z, a, bb = jnp.split(p, [DN_QKV_WIDTH, DN_QKV_WIDTH + DN_V_WIDTH,
                                  DN_QKV_WIDTH + DN_V_WIDTH + 2 * DN_HEADS], axis=-1)
    qkv = short_conv_silu(qkv, conv_w, rows, cols).astype(jnp.float32)
    q, k, v = jnp.split(qkv, [DN_QK_WIDTH, 2 * DN_QK_WIDTH], axis=-1)
    q = l2norm(q.reshape(b_, l_, DN_HEADS, DN_DK)).transpose(0, 2, 1, 3) * (DN_DK ** -0.5)
    k = l2norm(k.reshape(b_, l_, DN_HEADS, DN_DK)).transpose(0, 2, 1, 3)
    v = v.reshape(b_, l_, DN_HEADS, DN_DV).transpose(0, 2, 1, 3)
    a = a.astype(jnp.float32).reshape(b_, l_, 2, DN_HEADS)
    bb = bb.astype(jnp.float32).reshape(b_, l_, 2, DN_HEADS)
    g = -jnp.exp(a_log.astype(jnp.float32)) * jax.nn.softplus(a + dt_bias.astype(jnp.float32))
    beta = jax.nn.sigmoid(bb)
    g = jnp.transpose(g, (2, 0, 3, 1))
    beta = jnp.transpose(beta, (2, 0, 3, 1))
    return q, k, v, z, g, beta


def delta_output(o, z, norm_g, w_out):
    b_, h_, l_, dv = o.shape
    o = o * lax.rsqrt(jnp.mean(o * o, axis=-1, keepdims=True) + EPS) * norm_g.astype(jnp.float32)
    o = o.transpose(0, 2, 1, 3).reshape(b_, l_, h_ * dv).astype(z.dtype)
    return (o * jax.nn.silu(z)) @ w_out


def delta_mix(h_lat, h_ctx, w_in, conv_w, a_log, dt_bias, norm_g, w_out, rows, ctx_output):
    b_ = h_lat.shape[0]
    ql, kl, vl, zl, gl, bl = delta_project(h_lat, w_in, conv_w, a_log, dt_bias, rows, GRID_W)
    qc, kc, vc, zc, gc, bc = delta_project(h_ctx, w_in, conv_w, a_log, dt_bias, 1, h_ctx.shape[1])
    s0 = jnp.zeros((b_, DN_HEADS, DN_DK, DN_DV), jnp.float32)
    o_lat = 0.0
    o_ctx = 0.0
    for d in range(2):
        f = (lambda t: jnp.flip(t, axis=2)) if d == 1 else (lambda t: t)
        oc, s_ctx = gated_delta_chunked(f(qc), f(kc), f(vc), f(gc[d]), f(bc[d]), s0, ctx_output)
        ol, _ = gated_delta_chunked(f(ql), f(kl), f(vl), f(gl[d]), f(bl[d]), s_ctx, True)
        o_lat = o_lat + f(ol)
        if ctx_output:
            o_ctx = o_ctx + f(oc)
    out_lat = delta_output(o_lat, zl, norm_g, w_out)
    out_ctx = delta_output(o_ctx, zc, norm_g, w_out) if ctx_output else None
    return out_lat, out_ctx


def setup_inputs(seed: int = 0) -> dict:
    key = jax.random.key(seed)
    ks = jax.random.split(key, 20)
    f32 = jnp.float32
    D = D_MODEL
    nrm = lambda k, shape, s: jax.random.normal(k, shape, f32) * s
    log_dt = jax.random.uniform(ks[15], (N_DELTA_LAYERS, 2, DN_HEADS), f32,
                                math.log(1e-3), math.log(1e-1))
    dt = jnp.exp(log_dt)
    return {
        "x": nrm(ks[0], (BATCH, SEQ, D), 1.0),
        "c": nrm(ks[1], (BATCH, D), 1.0),
        "ctx": nrm(ks[2], (BATCH, CTX_LEN, D), 1.0),
        "c_ctx": nrm(ks[3], (D,), 1.0),
        "mod_w": nrm(ks[4], (DEPTH, D, 3 * D), 0.5 * D ** -0.5),
        "mod_b": nrm(ks[5], (DEPTH, 3 * D), 0.01),
        "norm_g": 1.0 + nrm(ks[6], (DEPTH, D), 0.01),
        "final_g": 1.0 + nrm(ks[7], (D,), 0.01),
        "fn_w_in": nrm(ks[8], (N_FOURIER_LAYERS, D, 2 * FN_WIDTH), D ** -0.5),
        "fn_w_grp": nrm(ks[9], (N_FOURIER_LAYERS, FN_GROUPS, FN_GROUP_DIM, FN_GROUP_DIM), FN_GROUP_DIM ** -0.5),
        "fn_w_out": nrm(ks[10], (N_FOURIER_LAYERS, FN_WIDTH, D), FN_WIDTH ** -0.5),
        "dn_w_in": nrm(ks[11], (N_DELTA_LAYERS, D, DN_PROJ_WIDTH), D ** -0.5),
        "dn_conv": nrm(ks[12], (N_DELTA_LAYERS, DN_CONV, DN_CONV, DN_QKV_WIDTH), 1.0 / DN_CONV),
        "dn_a_log": jnp.log(jax.random.uniform(ks[13], (N_DELTA_LAYERS, 2, DN_HEADS), f32, 1.0, 16.0)),
        "dn_dt_bias": dt + jnp.log(-jnp.expm1(-dt)),
        "dn_norm_g": 1.0 + nrm(ks[14], (N_DELTA_LAYERS, DN_DV), 0.01),
        "dn_w_out": nrm(ks[16], (N_DELTA_LAYERS, DN_V_WIDTH, D), DN_V_WIDTH ** -0.5),
    }


def reference(x, c, ctx, c_ctx, mod_w, mod_b, norm_g, final_g, fn_w_in, fn_w_grp, fn_w_out,
              dn_w_in, dn_conv, dn_a_log, dn_dt_bias, dn_norm_g, dn_w_out):
    rows = x.shape[1] // GRID_W
    h_lat, h_ctx = x, ctx
    cond_lat = c[:, None, :]
    cond_ctx = c_ctx[None, None, :]
    for i in range(DEPTH):
        last = i == DEPTH - 1
        mixer = i % N_MIXERS
        j = i // N_MIXERS
        sh_l, sc_l, gt_l = adaln(cond_lat, mod_w[i], mod_b[i])
        n_lat = rmsnorm(h_lat, norm_g[i]) * (1.0 + sc_l) + sh_l
        need_ctx = (not last) or mixer == 1
        if need_ctx:
            sh_c, sc_c, gt_c = adaln(cond_ctx, mod_w[i], mod_b[i])
            n_ctx = rmsnorm(h_ctx, norm_g[i]) * (1.0 + sc_c) + sh_c
        if mixer == 0:
            out_lat = fourier_mix(n_lat, fn_w_in[j], fn_w_grp[j], fn_w_out[j])
            out_ctx = fourier_mix(n_ctx, fn_w_in[j], fn_w_grp[j], fn_w_out[j]) if not last else None
        else:
            out_lat, out_ctx = delta_mix(n_lat, n_ctx, dn_w_in[j], dn_conv[j], dn_a_log[j],
                                         dn_dt_bias[j], dn_norm_g[j], dn_w_out[j], rows,
                                         not last)
        h_lat = h_lat + gt_l * out_lat
        if not last:
            h_ctx = h_ctx + gt_c * out_ctx
    return rmsnorm(h_lat, final_g)
```

```cpp
#include <hip/hip_runtime.h>
#include <hip/hip_cooperative_groups.h>
#include <cstdio>
namespace cg = cooperative_groups;

typedef _Float16 hf;
typedef hf h8 __attribute__((ext_vector_type(8)));
typedef hf h4 __attribute__((ext_vector_type(4)));
typedef hf h2 __attribute__((ext_vector_type(2)));
typedef float f16v __attribute__((ext_vector_type(16)));

#define DI __device__ __forceinline__

constexpr int D = 1024, SEQ = 8192, CTXL = 256, ROWS = SEQ + CTXL;
constexpr float EPS = 1e-6f;
constexpr size_t MiB = 1ull << 20;
constexpr size_t OFF_WDNIN = 0;
constexpr size_t OFF_WDNOUT = 13 * MiB;
constexpr size_t OFF_TW1 = 17 * MiB;
constexpr size_t OFF_TW2 = OFF_TW1 + 65536;
constexpr size_t OFF_T256 = OFF_TW2 + 32768;
constexpr size_t OFF_TWID = OFF_T256 + 262144;
constexpr size_t OFF_MOD = OFF_TWID + 65536;
constexpr size_t OFF_HCTX = 18 * MiB;
constexpr size_t OFF_AB = 19 * MiB;
constexpr size_t OFF_BAR = 21 * MiB;
constexpr size_t ARENA = 22 * MiB;
constexpr size_t OFF_WFNIN = ARENA + 0;
constexpr size_t OFF_WFNOUT = ARENA + 8 * MiB;
constexpr size_t OFF_WG = 252 * MiB;
constexpr size_t OFF_A0 = ARENA + 14 * MiB;
constexpr size_t OFF_YTL = ARENA + 31 * MiB;
constexpr size_t OFF_YTC = ARENA + 63 * MiB;
constexpr size_t OFF_SZ0 = ARENA + 64 * MiB;
constexpr size_t OFF_ZT = ARENA + 97 * MiB;
constexpr size_t OFF_VT = ARENA + 161 * MiB;
constexpr size_t OFF_QN = ARENA + 0;
constexpr size_t OFF_SZ1 = ARENA + 17 * MiB;
constexpr size_t OFF_REC = ARENA + 50 * MiB;
constexpr size_t OFF_KNT = ARENA + 116 * MiB;
constexpr size_t OFF_VTT = ARENA + 133 * MiB;
constexpr size_t OFF_O0 = ARENA + 166 * MiB;
constexpr size_t OFF_O1 = ARENA + 198 * MiB;
constexpr size_t OFF_KN = ARENA + 198 * MiB;
constexpr size_t WS_NEED = 254 * MiB;
constexpr int REC_BYTES = 31744;
constexpr int NSTEP = 132;
constexpr int LDS_BYTES = 78848;

struct Params {
  const float *x, *c, *ctx, *c_ctx, *mod_w, *mod_b, *norm_g, *final_g, *fn_w_in, *fn_w_grp, *fn_w_out,
      *dn_w_in, *dn_conv, *dn_a_log, *dn_dt_bias, *dn_norm_g, *dn_w_out;
  float* out;
  char* ws;
  int ph_lo, ph_hi;
};

DI int tidx() {
  int t = threadIdx.x;
  asm volatile("" : "+v"(t));
  return t;
}
DI float silu_f(float v) { return v / (1.f + __expf(-v)); }
DI f16v mfma16(h8 a, h8 b, f16v c) { return __builtin_amdgcn_mfma_f32_32x32x16_f16(a, b, c, 0, 0, 0); }
DI uint4 ldg4(const void* p) { return *(const uint4*)p; }
DI int rowmap(int r, int hh) { return 8 * (r >> 2) + 4 * hh + (r & 3); }
DI h8 cvt8(const f16v& a, int s) {
  h8 r;
#pragma unroll
  for (int j = 0; j < 8; ++j) r[j] = (hf)a[8 * s + j];
  return r;
}

constexpr int LDP = 40;
template <bool SWAP, class AF, class BF>
DI void gemm_main(hf* lds, int K, AF arow, BF brow, f16v (&acc)[2][2]) {
  const int tid = tidx(), lane = tid & 63, wid = tid >> 6;
  const int wr = wid >> 1, wc = wid & 1;
  hf* sA = lds;
  hf* sB = lds + 2 * 128 * LDP;
  const int lr = tid >> 2, kc = (tid & 3) * 8;
  const hf* pa0 = arow(lr) + kc;
  const hf* pa1 = arow(lr + 64) + kc;
  const hf* pb0 = brow(lr) + kc;
  const hf* pb1 = brow(lr + 64) + kc;
#pragma unroll
  for (int i = 0; i < 2; ++i)
#pragma unroll
    for (int j = 0; j < 2; ++j)
#pragma unroll
      for (int r = 0; r < 16; ++r) acc[i][j][r] = 0.f;
  uint4 ra0 = ldg4(pa0), ra1 = ldg4(pa1), rb0 = ldg4(pb0), rb1 = ldg4(pb1);
  const int wo0 = lr * LDP + kc, wo1 = (lr + 64) * LDP + kc;
  *(uint4*)(sA + wo0) = ra0;
  *(uint4*)(sA + wo1) = ra1;
  *(uint4*)(sB + wo0) = rb0;
  *(uint4*)(sB + wo1) = rb1;
  __syncthreads();
  const int nk = K >> 5;
  const int aoff = (wr * 64 + (lane & 31)) * LDP + (lane >> 5) * 8;
  const int boff = (wc * 64 + (lane & 31)) * LDP + (lane >> 5) * 8;
  for (int kt = 0; kt < nk; ++kt) {
    const int cur = kt & 1;
    const bool more = (kt + 1 < nk);
    if (more) {
      const int ko = (kt + 1) * 32;
      ra0 = ldg4(pa0 + ko);
      ra1 = ldg4(pa1 + ko);
      rb0 = ldg4(pb0 + ko);
      rb1 = ldg4(pb1 + ko);
    }
    const hf* cA = sA + cur * 128 * LDP;
    const hf* cB = sB + cur * 128 * LDP;
#pragma unroll
    for (int ks = 0; ks < 2; ++ks) {
      h8 a0 = *(const h8*)(cA + aoff + ks * 16), a1 = *(const h8*)(cA + aoff + 32 * LDP + ks * 16);
      h8 b0 = *(const h8*)(cB + boff + ks * 16), b1 = *(const h8*)(cB + boff + 32 * LDP + ks * 16);
      if (SWAP) {
        acc[0][0] = mfma16(b0, a0, acc[0][0]);
        acc[0][1] = mfma16(b1, a0, acc[0][1]);
        acc[1][0] = mfma16(b0, a1, acc[1][0]);
        acc[1][1] = mfma16(b1, a1, acc[1][1]);
      } else {
        acc[0][0] = mfma16(a0, b0, acc[0][0]);
        acc[0][1] = mfma16(a0, b1, acc[0][1]);
        acc[1][0] = mfma16(a1, b0, acc[1][0]);
        acc[1][1] = mfma16(a1, b1, acc[1][1]);
      }
    }
    if (more) {
      hf* nA = sA + (cur ^ 1) * 128 * LDP;
      hf* nB = sB + (cur ^ 1) * 128 * LDP;
      *(uint4*)(nA + wo0) = ra0;
      *(uint4*)(nA + wo1) = ra1;
      *(uint4*)(nB + wo0) = rb0;
      *(uint4*)(nB + wo1) = rb1;
    }
    __syncthreads();
  }
}
template <bool SWAP, class AF, class BF>
DI void gemm_main2(hf* lds, int K, AF arow, BF brow, f16v (&acc)[2][2]) {
  const int tid = tidx(), lane = tid & 63, wid = tid >> 6;
  const int wr = wid >> 1, wc = wid & 1;
  char* ldsb = (char*)lds;
  const int rsub = lane >> 2, cp = lane & 3;
  const int r0 = (wid * 2) * 16 + rsub, r1 = (wid * 2 + 1) * 16 + rsub;
  const int cl0 = (cp ^ ((r0 >> 2) & 3)) * 8, cl1 = (cp ^ ((r1 >> 2) & 3)) * 8;
  const hf* pa0 = arow(r0) + cl0;
  const hf* pa1 = arow(r1) + cl1;
  const hf* pb0 = brow(r0) + cl0;
  const hf* pb1 = brow(r1) + cl1;
  const int dA0 = __builtin_amdgcn_readfirstlane(wid) * 2048, dA1 = dA0 + 1024;
#pragma unroll
  for (int i = 0; i < 2; ++i)
#pragma unroll
    for (int j = 0; j < 2; ++j)
#pragma unroll
      for (int r = 0; r < 16; ++r) acc[i][j][r] = 0.f;
  auto issue = [&](int kt) {
    char* st = ldsb + (kt & 3) * 16384;
    const int ko = kt * 32;
    __builtin_amdgcn_global_load_lds((const unsigned*)(pa0 + ko), (unsigned*)(st + dA0), 16, 0, 0);
    __builtin_amdgcn_global_load_lds((const unsigned*)(pa1 + ko), (unsigned*)(st + dA1), 16, 0, 0);
    __builtin_amdgcn_global_load_lds((const unsigned*)(pb0 + ko), (unsigned*)(st + 8192 + dA0), 16, 0, 0);
    __builtin_amdgcn_global_load_lds((const unsigned*)(pb1 + ko), (unsigned*)(st + 8192 + dA1), 16, 0, 0);
  };
  const int nk = K >> 5;
  issue(0);
  issue(1);
  issue(2);
  const int l31 = lane & 31, hh = lane >> 5, swz = (l31 >> 2) & 3;
  const int fo0 = ((0 + hh) ^ swz) * 16, fo1 = ((2 + hh) ^ swz) * 16;
  const int arb = (wr * 64 + l31) * 64, brb = 8192 + (wc * 64 + l31) * 64;
  for (int kt = 0; kt < nk; ++kt) {
    if (kt + 2 < nk) asm volatile("s_waitcnt vmcnt(8) lgkmcnt(0)" ::: "memory");
    else if (kt + 1 < nk) asm volatile("s_waitcnt vmcnt(4) lgkmcnt(0)" ::: "memory");
    else asm volatile("s_waitcnt vmcnt(0)" ::: "memory");
    __builtin_amdgcn_s_barrier();
    const char* st = ldsb + (kt & 3) * 16384;
#pragma unroll
    for (int ks = 0; ks < 2; ++ks) {
      const int fo = ks ? fo1 : fo0;
      if (ks == 1 && kt + 3 < nk) issue(kt + 3);
      h8 a0 = *(const h8*)(st + arb + fo), a1 = *(const h8*)(st + arb + 2048 + fo);
      h8 b0 = *(const h8*)(st + brb + fo), b1 = *(const h8*)(st + brb + 2048 + fo);
      if (SWAP) {
        acc[0][0] = mfma16(b0, a0, acc[0][0]);
        acc[0][1] = mfma16(b1, a0, acc[0][1]);
        acc[1][0] = mfma16(b0, a1, acc[1][0]);
        acc[1][1] = mfma16(b1, a1, acc[1][1]);
      } else {
        acc[0][0] = mfma16(a0, b0, acc[0][0]);
        acc[0][1] = mfma16(a0, b1, acc[0][1]);
        acc[1][0] = mfma16(a1, b0, acc[1][0]);
        acc[1][1] = mfma16(a1, b1, acc[1][1]);
      }
    }
  }
  __builtin_amdgcn_s_barrier();
}
template <bool SWAP, class F>
DI void gemm_epi(f16v (&acc)[2][2], F f) {
  const int tid = tidx(), lane = tid & 63, wid = tid >> 6;
  const int wr = wid >> 1, wc = wid & 1, hh = lane >> 5, l31 = lane & 31;
#pragma unroll
  for (int i = 0; i < 2; ++i)
#pragma unroll
    for (int j = 0; j < 2; ++j)
#pragma unroll
      for (int q = 0; q < 4; ++q) {
        if (SWAP) {
          int m = wr * 64 + i * 32 + l31, n0 = wc * 64 + j * 32 + 8 * q + 4 * hh;
          f(m, n0, acc[i][j][4 * q], acc[i][j][4 * q + 1], acc[i][j][4 * q + 2], acc[i][j][4 * q + 3]);
        } else {
          int m0 = wr * 64 + i * 32 + 8 * q + 4 * hh, n = wc * 64 + j * 32 + l31;
          f(m0, n, acc[i][j][4 * q], acc[i][j][4 * q + 1], acc[i][j][4 * q + 2], acc[i][j][4 * q + 3]);
        }
      }
}
DI h4 mk4(float a, float b, float c, float d) {
  h4 r;
  r[0] = (hf)a; r[1] = (hf)b; r[2] = (hf)c; r[3] = (hf)d;
  return r;
}

DI void transpose_tile(const float* src, int K, int N, hf* dst, int tk, int tn, float* lds) {
  const int tid = tidx();
  const int c4 = (tid & 15) * 4, n = tn * 64 + c4;
#pragma unroll
  for (int i = 0; i < 4; ++i) {
    int k = (tid >> 4) + i * 16;
    float4 v = make_float4(0.f, 0.f, 0.f, 0.f);
    if (n < N) v = *(const float4*)(src + (size_t)(tk * 64 + k) * N + n);
    lds[k * 65 + c4 + 0] = v.x;
    lds[k * 65 + c4 + 1] = v.y;
    lds[k * 65 + c4 + 2] = v.z;
    lds[k * 65 + c4 + 3] = v.w;
  }
  __syncthreads();
#pragma unroll
  for (int i = 0; i < 2; ++i) {
    int q = tid + i * 256;
    int nn = q >> 3, k8 = (q & 7) * 8;
    h8 o;
#pragma unroll
    for (int j = 0; j < 8; ++j) o[j] = (hf)lds[(k8 + j) * 65 + nn];
    *(h8*)(dst + (size_t)(tn * 64 + nn) * K + tk * 64 + k8) = o;
  }
  __syncthreads();
}

DI void phase_prep(const Params& p, char* ldsc, int which) {
  const int tid = tidx();
  float* lds = (float*)ldsc;
  size_t wsz_ = 0;
  asm volatile("" : "+s"(wsz_));
  char* ws = p.ws + wsz_;
  constexpr int N1 = 1024, N2 = 512, N3 = 1568, N4 = 512, N5 = 512, N6 = 736, N7 = 384;
  constexpr int TOT = N1 + N2 + N3 + N4 + N5 + N6 + N7;
  for (int it = blockIdx.x; it < TOT; it += gridDim.x) {
    int i = it;
    {
      const bool l0 = (i < N1 + N2);
      if (l0 != (which == 1)) continue;
    }
    if (i < N1) { transpose_tile(p.fn_w_in, 1024, 4096, (hf*)(ws + OFF_WFNIN), i / 64, i % 64, lds); continue; }
    i -= N1;
    if (i < N2) { transpose_tile(p.fn_w_out, 2048, 1024, (hf*)(ws + OFF_WFNOUT), i / 16, i % 16, lds); continue; }
    i -= N2;
    if (i < N3) { transpose_tile(p.dn_w_in, 1024, 6176, (hf*)(ws + OFF_WDNIN), i / 98, i % 98, lds); continue; }
    i -= N3;
    if (i < N4) { transpose_tile(p.dn_w_out, 2048, 1024, (hf*)(ws + OFF_WDNOUT), i / 16, i % 16, lds); continue; }
    i -= N4;
    if (i < N5) {
      const int g = i >> 6, c0 = (i & 63) * 4, d = tid;
      float sv, cv;
      sincospif((float)tid / 128.f, &sv, &cv);
      lds[tid] = cv;
      lds[256 + tid] = sv;
      __syncthreads();
      float ac[4], as[4];
#pragma unroll
      for (int j = 0; j < 4; ++j) { ac[j] = 0.f; as[j] = 0.f; }
      const float* w = p.fn_w_grp + (size_t)g * 65536 + d;
#pragma unroll 4
      for (int m = 0; m < 256; ++m) {
        float wv = w[m * 256];
#pragma unroll
        for (int j = 0; j < 4; ++j) {
          int idx = (m * (c0 + j)) & 255;
          ac[j] += lds[idx] * wv;
          as[j] += lds[256 + idx] * wv;
        }
      }
      hf* dst = (hf*)(ws + OFF_WG) + (size_t)(g * 256 + d) * 512;
      *(h4*)(dst + c0) = mk4(ac[0] * 0.0625f, ac[1] * 0.0625f, ac[2] * 0.0625f, ac[3] * 0.0625f);
      *(h4*)(dst + 256 + c0) = mk4(as[0] * 0.0625f, as[1] * 0.0625f, as[2] * 0.0625f, as[3] * 0.0625f);
      __syncthreads();
      continue;
    }
    i -= N5;
    if (i < N6) {
      int e = i * 256 + tid;
      if (e < 32768) {
        int n = e >> 7, l1 = e & 127;
        int im = (n >> 5) & 1, k1 = (n >> 6) * 32 + (n & 31);
        float sv, cv;
        sincospif((float)((k1 * l1) & 127) / 64.f, &sv, &cv);
        ((hf*)(ws + OFF_TW1))[e] = (hf)((im ? -sv : cv) * 0.08838834764831845f);
      } else if (e < 32768 + 16384) {
        int e2 = e - 32768;
        int n = e2 >> 7, kk = e2 & 127;
        int im = n >> 6, k2 = n & 63, l2 = kk & 63, hi = kk >> 6;
        float sv, cv;
        sincospif((float)((k2 * l2) & 63) / 32.f, &sv, &cv);
        float v = (im == 0) ? (hi ? sv : cv) : (hi ? cv : -sv);
        ((hf*)(ws + OFF_TW2))[e2] = (hf)(v * 0.125f);
      } else if (e < 32768 + 16384 + 131072) {
        int e2 = e - 49152;
        int n = e2 >> 8, l = e2 & 255;
        int im = n >> 8, k = n & 255;
        float sv, cv;
        sincospif((float)((k * l) & 255) / 128.f, &sv, &cv);
        ((hf*)(ws + OFF_T256))[e2] = (hf)((im ? -sv : cv) * 0.0625f);
      } else if (e < 32768 + 16384 + 131072 + 8192) {
        int j = e - 180224;
        float sv, cv;
        sincospif((float)j / 4096.f, &sv, &cv);
        ((float*)(ws + OFF_TWID))[2 * j] = cv;
        ((float*)(ws + OFF_TWID))[2 * j + 1] = sv;
      }
      continue;
    }
    i -= N6;
    {
      const int q0 = i * 16, layer = q0 / 3072, n = (q0 % 3072) + (tid & 15), ks = tid >> 4;
      for (int e = tid; e < 3072; e += 256) {
        int cond = e >> 10, k = e & 1023;
        float v = cond == 0 ? p.c[k] : (cond == 1 ? p.c[1024 + k] : p.c_ctx[k]);
        lds[e] = silu_f(v);
      }
      __syncthreads();
      float a0 = 0.f, a1 = 0.f, a2 = 0.f;
      const float* w = p.mod_w + (size_t)layer * 1024 * 3072 + n;
#pragma unroll 16
      for (int k = ks * 64; k < ks * 64 + 64; ++k) {
        float wv = w[(size_t)k * 3072];
        a0 += lds[k] * wv;
        a1 += lds[1024 + k] * wv;
        a2 += lds[2048 + k] * wv;
      }
      float* red = lds + 3072;
      red[(ks * 3 + 0) * 16 + (tid & 15)] = a0;
      red[(ks * 3 + 1) * 16 + (tid & 15)] = a1;
      red[(ks * 3 + 2) * 16 + (tid & 15)] = a2;
      __syncthreads();
      if (tid < 48) {
        int cond = tid >> 4, cl = tid & 15;
        float sacc = 0.f;
#pragma unroll
        for (int j = 0; j < 16; ++j) sacc += red[(j * 3 + cond) * 16 + cl];
        int nn = (q0 % 3072) + cl;
        ((float*)(ws + OFF_MOD))[(layer * 3 + cond) * 3072 + nn] = sacc + p.mod_b[layer * 3072 + nn];
      }
      __syncthreads();
    }
  }
}

DI void phase_normmod(const Params& p, int b, int layer) {
  const int tid = tidx(), lane = tid & 63, wid = tid >> 6;
  size_t wsz_ = 0;
  asm volatile("" : "+s"(wsz_));
  char* ws = p.ws + wsz_;
  hf* A = (hf*)(ws + (layer == 0 ? OFF_A0 : OFF_QN));
  const float* modb = (const float*)(ws + OFF_MOD);
  const float* g = p.norm_g + layer * 1024;
  for (int it = blockIdx.x; it < ROWS / 4; it += gridDim.x) {
    const int r = it * 4 + wid;
    const float* src;
    int cond;
    if (r < SEQ) {
      src = (layer == 0 ? p.x : p.out) + ((size_t)b * SEQ + r) * D;
      cond = b;
    } else {
      src = (layer == 0) ? p.ctx + ((size_t)b * CTXL + (r - SEQ)) * D : (const float*)(ws + OFF_HCTX) + (size_t)(r - SEQ) * D;
      cond = 2;
    }
    const float* mb = modb + (layer * 3 + cond) * 3072;
    float4 v[4];
    float ss = 0.f;
#pragma unroll
    for (int k = 0; k < 4; ++k) {
      v[k] = *(const float4*)(src + k * 256 + lane * 4);
      ss += v[k].x * v[k].x + v[k].y * v[k].y + v[k].z * v[k].z + v[k].w * v[k].w;
    }
#pragma unroll
    for (int o = 32; o >= 1; o >>= 1) ss += __shfl_xor(ss, o);
    const float rstd = rsqrtf(ss * (1.f / 1024.f) + EPS);
#pragma unroll
    for (int k = 0; k < 4; ++k) {
      int col = k * 256 + lane * 4;
      float4 gg = *(const float4*)(g + col), sh = *(const float4*)(mb + col), sc = *(const float4*)(mb + 1024 + col);
      h4 o = mk4(v[k].x * rstd * gg.x * (1.f + sc.x) + sh.x, v[k].y * rstd * gg.y * (1.f + sc.y) + sh.y,
                 v[k].z * rstd * gg.z * (1.f + sc.z) + sh.z, v[k].w * rstd * gg.w * (1.f + sc.w) + sh.w);
      *(h4*)(A + (size_t)r * D + col) = o;
      if (layer == 0 && r >= SEQ) *(float4*)((float*)(ws + OFF_HCTX) + (size_t)(r - SEQ) * D + col) = v[k];
    }
  }
}

DI void phase_gemm1(const Params& p, hf* lds) {
  size_t wsz_ = 0;
  asm volatile("" : "+s"(wsz_));
  char* ws = p.ws + wsz_;
  const hf* A = (const hf*)(ws + OFF_A0);
  const hf* W = (const hf*)(ws + OFF_WFNIN);
  hf* ytl = (hf*)(ws + OFF_YTL);
  hf* ytc = (hf*)(ws + OFF_YTC);
  hf* sz = (hf*)(ws + OFF_SZ0);
  for (int t = blockIdx.x; t < 66 * 32; t += gridDim.x) {
    const int mt = t >> 5, nt = t & 31;
    auto arow = [&](int r) -> const hf* {
      int row = (mt < 64) ? (r * 64 + mt) : (SEQ + (mt - 64) * 128 + r);
      return A + (size_t)row * D;
    };
    auto brow = [&](int r) -> const hf* { return W + (size_t)(nt * 128 + r) * D; };
    f16v acc[2][2];
    if (nt < 16) {
      gemm_main2<false>(lds, D, arow, brow, acc);
      gemm_epi<false>(acc, [&](int m0, int n, float a, float b, float c, float d) {
        int col = nt * 128 + n;
        h4 o = mk4(a, b, c, d);
        if (mt < 64) *(h4*)(ytl + ((size_t)col * 64 + mt) * 128 + m0) = o;
        else *(h4*)(ytc + (size_t)col * 256 + (mt - 64) * 128 + m0) = o;
      });
    } else {
      gemm_main2<true>(lds, D, arow, brow, acc);
      gemm_epi<true>(acc, [&](int m, int n0, float a, float b, float c, float d) {
        int row = (mt < 64) ? (m * 64 + mt) : (SEQ + (mt - 64) * 128 + m);
        int col = (nt - 16) * 128 + n0;
        *(h4*)(sz + (size_t)row * 2048 + col) = mk4(silu_f(a), silu_f(b), silu_f(c), silu_f(d));
      });
    }
  }
}

DI void phase_stageA(const Params& p, hf* lds) {
  size_t wsz_ = 0;
  asm volatile("" : "+s"(wsz_));
  char* ws = p.ws + wsz_;
  const hf* ytl = (const hf*)(ws + OFF_YTL);
  const hf* ytc = (const hf*)(ws + OFF_YTC);
  const hf* w1 = (const hf*)(ws + OFF_TW1);
  const hf* w256 = (const hf*)(ws + OFF_T256);
  const float2* tw = (const float2*)(ws + OFF_TWID);
  hf* zt = (hf*)(ws + OFF_ZT);
  hf* vt = (hf*)(ws + OFF_VT);
  const int lane = tidx() & 63, wid = tidx() >> 6, wr = wid >> 1, wc = wid & 1, hh = lane >> 5, l31 = lane & 31;
  for (int t = blockIdx.x; t < 2048 + 64; t += gridDim.x) {
    f16v acc[2][2];
    if (t < 2048) {
      const int mt = t >> 1, nt = t & 1;
      auto arow = [&](int r) -> const hf* { return ytl + (size_t)(mt * 128 + r) * 128; };
      auto brow = [&](int r) -> const hf* { return w1 + (size_t)(nt * 128 + r) * 128; };
      gemm_main2<false>(lds, 128, arow, brow, acc);
      const int k1 = (nt * 2 + wc) * 32 + l31;
#pragma unroll
      for (int i = 0; i < 2; ++i)
#pragma unroll
        for (int q = 0; q < 4; ++q) {
          const int m0 = mt * 128 + wr * 64 + i * 32 + 8 * q + 4 * hh;
          const int col = m0 >> 6, l2 = m0 & 63;
          float zr[4], zi[4];
#pragma unroll
          for (int e = 0; e < 4; ++e) {
            float2 cs = tw[(k1 * (l2 + e)) & 8191];
            float re = acc[i][0][4 * q + e], im = acc[i][1][4 * q + e];
            zr[e] = re * cs.x + im * cs.y;
            zi[e] = im * cs.x - re * cs.y;
          }
          size_t base = (((size_t)k1 * 2048 + col) * 2) * 64 + l2;
          *(h4*)(zt + base) = mk4(zr[0], zr[1], zr[2], zr[3]);
          *(h4*)(zt + base + 64) = mk4(zi[0], zi[1], zi[2], zi[3]);
        }
    } else {
      const int tt = t - 2048, mt = tt >> 2, nt = tt & 3;
      auto arow = [&](int r) -> const hf* { return ytc + (size_t)(mt * 128 + r) * 256; };
      auto brow = [&](int r) -> const hf* { return w256 + (size_t)(nt * 128 + r) * 256; };
      gemm_main2<false>(lds, 256, arow, brow, acc);
      gemm_epi<false>(acc, [&](int m0, int n, float a, float b, float c, float d) {
        int col = mt * 128 + m0, nn = nt * 128 + n;
        int im = nn >> 8, k = nn & 255, g = col >> 8, cc = col & 255;
        *(h4*)(vt + (size_t)(SEQ + k) * 4096 + g * 512 + im * 256 + cc) = mk4(a, b, c, d);
      });
    }
  }
}

DI void phase_stageB(const Params& p, hf* lds) {
  size_t wsz_ = 0;
  asm volatile("" : "+s"(wsz_));
  char* ws = p.ws + wsz_;
  const hf* zt = (const hf*)(ws + OFF_ZT);
  const hf* w2 = (const hf*)(ws + OFF_TW2);
  hf* vt = (hf*)(ws + OFF_VT);
  for (int t = blockIdx.x; t < 2048; t += gridDim.x) {
    f16v acc[2][2];
    auto arow = [&](int r) -> const hf* { return zt + (size_t)(t * 128 + r) * 128; };
    auto brow = [&](int r) -> const hf* { return w2 + (size_t)r * 128; };
    gemm_main2<false>(lds, 128, arow, brow, acc);
    gemm_epi<false>(acc, [&](int m0, int n, float a, float b, float c, float d) {
      int m = t * 128 + m0;
      int k1 = m >> 11, col = m & 2047, im = n >> 6, k2 = n & 63;
      int g = col >> 8, cc = col & 255;
      *(h4*)(vt + (size_t)(k1 + 128 * k2) * 4096 + g * 512 + im * 256 + cc) = mk4(a, b, c, d);
    });
  }
}

DI void phase_group(const Params& p, hf* lds) {
  size_t wsz_ = 0;
  asm volatile("" : "+s"(wsz_));
  char* ws = p.ws + wsz_;
  const hf* vt = (const hf*)(ws + OFF_VT);
  const hf* wg = (const hf*)(ws + OFF_WG);
  hf* sz = (hf*)(ws + OFF_SZ0);
  for (int t = blockIdx.x; t < 66 * 16; t += gridDim.x) {
    const int mt = t >> 4, g = (t >> 1) & 7, nt = t & 1;
    f16v acc[2][2];
    auto arow = [&](int r) -> const hf* { return vt + (size_t)(mt * 128 + r) * 4096 + g * 512; };
    auto brow = [&](int r) -> const hf* { return wg + (size_t)(g * 256 + nt * 128 + r) * 512; };
    gemm_main2<true>(lds, 512, arow, brow, acc);
    gemm_epi<true>(acc, [&](int m, int n0, float a, float b, float c, float d) {
      hf* q = sz + (size_t)(mt * 128 + m) * 2048 + g * 256 + nt * 128 + n0;
      h4 s = *(const h4*)q;
      *(h4*)q = mk4(a * (float)s[0], b * (float)s[1], c * (float)s[2], d * (float)s[3]);
    });
  }
}

DI void phase_outproj(const Params& p, int b, int layer, hf* lds) {
  size_t wsz_ = 0;
  asm volatile("" : "+s"(wsz_));
  char* ws = p.ws + wsz_;
  const hf* A = (const hf*)(ws + (layer == 0 ? OFF_SZ0 : OFF_SZ1));
  const hf* W = (const hf*)(ws + (layer == 0 ? OFF_WFNOUT : OFF_WDNOUT));
  const float* modb = (const float*)(ws + OFF_MOD);
  const int ntile = layer == 0 ? 512 + 128 : 512;
  for (int t = blockIdx.x; t < ntile; t += gridDim.x) {
    f16v acc[2][2];
    if (t < 512) {
      const int mt = t >> 3, nt = t & 7;
      auto arow = [&](int r) -> const hf* { return A + (size_t)(mt * 128 + r) * 2048; };
      auto brow = [&](int r) -> const hf* { return W + (size_t)(nt * 128 + r) * 2048; };
      gemm_main2<true>(lds, 2048, arow, brow, acc);
      gemm_epi<true>(acc, [&](int m, int n0, float a0, float a1, float a2, float a3) {
        int row = mt * 128 + m, col = nt * 128 + n0;
        float* dst = p.out + ((size_t)b * SEQ + row) * D + col;
        const float* src = (layer == 0) ? p.x + ((size_t)b * SEQ + row) * D + col : dst;
        float4 gt = *(const float4*)(modb + (layer * 3 + b) * 3072 + 2048 + col);
        float4 s = *(const float4*)src;
        *(float4*)dst = make_float4(s.x + gt.x * a0, s.y + gt.y * a1, s.z + gt.z * a2, s.w + gt.w * a3);
      });
    } else {
      const int it = t - 512, tile = it >> 3, ksp = it & 7;
      const int mt = 64 + (tile >> 3), nt = tile & 7;
      auto arow = [&](int r) -> const hf* { return A + (size_t)(mt * 128 + r) * 2048 + ksp * 256; };
      auto brow = [&](int r) -> const hf* { return W + (size_t)(nt * 128 + r) * 2048 + ksp * 256; };
      gemm_main2<true>(lds, 256, arow, brow, acc);
      gemm_epi<true>(acc, [&](int m, int n0, float a0, float a1, float a2, float a3) {
        int row = mt * 128 + m - SEQ, col = nt * 128 + n0;
        float* dst = (float*)(ws + OFF_HCTX) + (size_t)row * D + col;
        float4 gt = *(const float4*)(modb + (0 * 3 + 2) * 3072 + 2048 + col);
        unsafeAtomicAdd(dst + 0, gt.x * a0);
        unsafeAtomicAdd(dst + 1, gt.y * a1);
        unsafeAtomicAdd(dst + 2, gt.z * a2);
        unsafeAtomicAdd(dst + 3, gt.w * a3);
      });
    }
  }
}

DI void phase_inproj1(const Params& p, hf* lds) {
  size_t wsz_ = 0;
  asm volatile("" : "+s"(wsz_));
  char* ws = p.ws + wsz_;
  const hf* A = (const hf*)(ws + OFF_QN);
  const hf* W = (const hf*)(ws + OFF_WDNIN);
  hf* pre = (hf*)(ws + OFF_REC);
  hf* sz = (hf*)(ws + OFF_SZ1);
  float* ab = (float*)(ws + OFF_AB);
  for (int t = blockIdx.x; t < 66 * 49; t += gridDim.x) {
    const int mt = t / 49, nt = t % 49;
    f16v acc[2][2];
    auto arow = [&](int r) -> const hf* { return A + (size_t)(mt * 128 + r) * D; };
    auto brow = [&](int r) -> const hf* { return W + (size_t)(nt * 128 + r) * D; };
    gemm_main2<true>(lds, D, arow, brow, acc);
    gemm_epi<true>(acc, [&](int m, int n0, float a, float b, float c, float d) {
      int row = mt * 128 + m, col = nt * 128 + n0;
      if (nt < 32) *(h4*)(pre + (size_t)row * 4096 + col) = mk4(a, b, c, d);
      else if (nt < 48) *(h4*)(sz + (size_t)row * 2048 + (col - 4096)) = mk4(silu_f(a), silu_f(b), silu_f(c), silu_f(d));
      else if (col - 6144 < 32) *(float4*)(ab + (size_t)row * 32 + (col - 6144)) = make_float4(a, b, c, d);
    });
  }
}

DI void phase_conv(const Params& p, char* ldsc) {
  size_t wsz_ = 0;
  asm volatile("" : "+s"(wsz_));
  char* ws = p.ws + wsz_;
  const int tid = tidx();
  const hf* pre = (const hf*)(ws + OFF_REC);
  hf* tile = (hf*)ldsc;
  const int ch8 = tid & 15, tk = tid >> 4;
  for (int it = blockIdx.x; it < 132 * 32; it += gridDim.x) {
    const int rr = it >> 5, cb = it & 31;
    const bool isctx = rr >= 128;
    const int T = isctx ? CTXL : SEQ;
    const int t0 = isctx ? (rr - 128) * 64 : rr * 64;
    int chbase, kind, head, dvo = 0;
    if (cb < 8) { kind = 0; head = cb; chbase = cb * 128; }
    else if (cb < 16) { kind = 1; head = cb - 8; chbase = 1024 + (cb - 8) * 128; }
    else { kind = 2; head = (cb - 16) >> 1; dvo = ((cb - 16) & 1) * 128; chbase = 2048 + (cb - 16) * 128; }
    const int ch = chbase + ch8 * 8;
    float w[9][8];
#pragma unroll
    for (int k = 0; k < 9; ++k) {
      float4 wa = *(const float4*)(p.dn_conv + k * 4096 + ch), wb = *(const float4*)(p.dn_conv + k * 4096 + ch + 4);
      w[k][0] = wa.x; w[k][1] = wa.y; w[k][2] = wa.z; w[k][3] = wa.w;
      w[k][4] = wb.x; w[k][5] = wb.y; w[k][6] = wb.z; w[k][7] = wb.w;
    }
    auto ldw = [&](int di, int col) -> h8 {
      int row;
      bool ok;
      if (!isctx) {
        int r2 = rr + di - 1;
        ok = (r2 >= 0) && (r2 < 128) && (col >= 0) && (col < 64);
        row = r2 * 64 + col;
      } else {
        int p2 = t0 + col;
        ok = (di == 1) && (p2 >= 0) && (p2 < 256);
        row = SEQ + p2;
      }
      h8 v;
#pragma unroll
      for (int e = 0; e < 8; ++e) v[e] = (hf)0.f;
      if (ok) v = *(const h8*)(pre + (size_t)row * 4096 + ch);
      return v;
    };
    const int c0 = tk * 4;
    h8 wl[3], wm[3], wrr[3];
#pragma unroll
    for (int di = 0; di < 3; ++di) { wl[di] = ldw(di, c0 - 1); wm[di] = ldw(di, c0); }
#pragma unroll
    for (int pp = 0; pp < 4; ++pp) {
      const int cc = c0 + pp;
      float y[8];
#pragma unroll
      for (int e = 0; e < 8; ++e) y[e] = 0.f;
#pragma unroll
      for (int di = 0; di < 3; ++di) {
        wrr[di] = ldw(di, cc + 1);
#pragma unroll
        for (int e = 0; e < 8; ++e)
          y[e] += (float)wl[di][e] * w[di * 3 + 0][e] + (float)wm[di][e] * w[di * 3 + 1][e] + (float)wrr[di][e] * w[di * 3 + 2][e];
      }
#pragma unroll
      for (int di = 0; di < 3; ++di) { wl[di] = wm[di]; wm[di] = wrr[di]; }
      float ss = 0.f;
#pragma unroll
      for (int e = 0; e < 8; ++e) { y[e] = silu_f(y[e]); ss += y[e] * y[e]; }
      if (kind < 2) {
        ss += __shfl_xor(ss, 1);
        ss += __shfl_xor(ss, 2);
        ss += __shfl_xor(ss, 4);
        ss += __shfl_xor(ss, 8);
        float sc = rsqrtf(ss + EPS) * (kind == 0 ? 0.08838834764831845f : 1.f);
#pragma unroll
        for (int e = 0; e < 8; ++e) y[e] *= sc;
      }
      h8 o;
#pragma unroll
      for (int e = 0; e < 8; ++e) o[e] = (hf)y[e];
      if (kind < 2) {
        hf* base = (hf*)(ws + (kind == 0 ? OFF_QN : OFF_KN)) + (isctx ? (size_t)8 * SEQ * 128 : 0);
        *(h8*)(base + ((size_t)head * T + t0 + cc) * 128 + ch8 * 8) = o;
      }
      if (kind >= 1) {
#pragma unroll
        for (int e = 0; e < 8; ++e) tile[(ch8 * 8 + e) * 72 + cc] = o[e];
      }
    }
    if (kind >= 1) {
      __syncthreads();
      const int chunk = rr;
      hf* base;
      if (kind == 1) base = (hf*)(ws + OFF_KNT) + ((size_t)(head * 132 + chunk) * 128) * 64;
      else base = (hf*)(ws + OFF_VTT) + ((size_t)(head * 132 + chunk) * 256 + dvo) * 64;
#pragma unroll
      for (int k = 0; k < 4; ++k) {
        int q = tid + 256 * k;
        int c = q >> 3, t8 = q & 7;
        h8 v = *(const h8*)(tile + c * 72 + t8 * 8);
        *(h8*)(base + (size_t)c * 64 + t8 * 8) = v;
      }
      __syncthreads();
    }
  }
}

DI void step_geom(int s, int d, bool& isctx, int& T, int& t0) {
  isctx = s < 4;
  int oc = isctx ? (d ? 3 - s : s) : (d ? 127 - (s - 4) : (s - 4));
  T = isctx ? CTXL : SEQ;
  t0 = oc * 64;
}
DI int step_chunk(int s, int d) {
  return (s < 4) ? 128 + (d ? 3 - s : s) : (d ? 127 - (s - 4) : (s - 4));
}

DI void phase_dprep(const Params& p, char* ldsc) {
  size_t wsz_ = 0;
  asm volatile("" : "+s"(wsz_));
  char* ws = p.ws + wsz_;
  const int tid = tidx(), lane = tid & 63, wid = tid >> 6, hh = lane >> 5, l31 = lane & 31;
  hf* kS = (hf*)ldsc;
  hf* qS = kS + 64 * 136;
  float* Ns = (float*)(qS + 64 * 136);
  hf* Tbs = (hf*)(Ns + 64 * 68);
  hf* Tws = Tbs + 64 * 72;
  float* gcs = (float*)(Tws + 64 * 72);
  float* bts = gcs + 64;
  const float* ab = (const float*)(ws + OFF_AB);
  for (int it = blockIdx.x; it < 8 * 2 * NSTEP; it += gridDim.x) {
    const int h = it / (2 * NSTEP), d = (it / NSTEP) & 1, s = it % NSTEP;
    bool isctx; int T, t0;
    step_geom(s, d, isctx, T, t0);
    const int row0 = isctx ? SEQ + t0 : t0;
    char* rec = ws + OFF_REC + (size_t)it * REC_BYTES;
    const hf* qn = (const hf*)(ws + OFF_QN) + (isctx ? (size_t)8 * SEQ * 128 : 0) + ((size_t)h * T + t0) * 128;
    const hf* kn = (const hf*)(ws + OFF_KN) + (isctx ? (size_t)8 * SEQ * 128 : 0) + ((size_t)h * T + t0) * 128;
    const hf* knt = (const hf*)(ws + OFF_KNT) + ((size_t)(h * 132 + step_chunk(s, d)) * 128) * 64;
    if (tid < 64) {
      const int pp = tid;
      float a = ab[(size_t)(row0 + pp) * 32 + d * 8 + h], bb = ab[(size_t)(row0 + pp) * 32 + 16 + d * 8 + h];
      float xx = a + p.dn_dt_bias[d * 8 + h];
      float sp = fmaxf(xx, 0.f) + log1pf(expf(-fabsf(xx)));
      float g = -expf(p.dn_a_log[d * 8 + h]) * sp;
      float beta = 1.f / (1.f + expf(-bb));
      float v = g;
#pragma unroll
      for (int o = 1; o < 64; o <<= 1) {
        float nb = d ? __shfl_down(v, o) : __shfl_up(v, o);
        bool ok = d ? (pp + o < 64) : (pp >= o);
        if (ok) v += nb;
      }
      gcs[pp] = v;
      bts[pp] = beta;
    }
#pragma unroll
    for (int k = 0; k < 4; ++k) {
      int q = tid + 256 * k;
      int r = q >> 4, c16 = q & 15;
      *(uint4*)(kS + r * 136 + c16 * 8) = ldg4(kn + (size_t)r * 128 + c16 * 8);
      *(uint4*)(qS + r * 136 + c16 * 8) = ldg4(qn + (size_t)r * 128 + c16 * 8);
    }
    __syncthreads();
    const float glast = d ? gcs[0] : gcs[63];
    {
      const int ta = wid >> 1, tb = wid & 1;
      f16v akk, aqk;
#pragma unroll
      for (int r = 0; r < 16; ++r) { akk[r] = 0.f; aqk[r] = 0.f; }
#pragma unroll
      for (int ks = 0; ks < 8; ++ks) {
        h8 fa = *(const h8*)(kS + (ta * 32 + l31) * 136 + ks * 16 + hh * 8);
        h8 fb = *(const h8*)(kS + (tb * 32 + l31) * 136 + ks * 16 + hh * 8);
        h8 fq = *(const h8*)(qS + (tb * 32 + l31) * 136 + ks * 16 + hh * 8);
        akk = mfma16(fa, fb, akk);
        aqk = mfma16(fa, fq, aqk);
      }
      const int pb = tb * 32 + l31;
      const float gb = gcs[pb];
      h8 f0, f1;
#pragma unroll
      for (int r = 0; r < 16; ++r) {
        const int pa = ta * 32 + rowmap(r, hh);
        const float ga = gcs[pa];
        bool strict = d ? (pb > pa) : (pb < pa);
        if (strict) {
          int i = d ? 63 - pa : pa, j = d ? 63 - pb : pb;
          Ns[i * 68 + j] = bts[pa] * akk[r] * __expf(ga - gb);
        }
        bool le = d ? (pa >= pb) : (pa <= pb);
        float v = le ? aqk[r] * __expf(gb - ga) : 0.f;
        if (r < 8) f0[r] = (hf)v; else f1[r - 8] = (hf)v;
      }
      if (!isctx) {
        int slot = (ta == tb) ? ta : ((d ? (ta > tb) : (ta < tb)) ? 2 : -1);
        if (slot >= 0) {
          hf* dst = (hf*)(rec + 16384 + 8192);
          *(h8*)(dst + ((slot * 2 + 0) * 64 + lane) * 8) = f0;
          *(h8*)(dst + ((slot * 2 + 1) * 64 + lane) * 8) = f1;
        }
      }
    }
    __syncthreads();
    float* Tf = (float*)kS;
    float* Xf = Tf + 64 * 68;
    if (wid < 2) {
      const int base = wid * 32, cl = lane & 31;
      int zofs = 0;
      asm volatile("" : "+v"(zofs));
      const float* Nz = Ns + zofs + base * 68 + base;
      float nrow[32];
#pragma unroll
      for (int i = 1; i < 32; ++i) nrow[i] = Nz[i * 68 + cl];
      float tt[32];
#pragma unroll
      for (int i = 0; i < 32; ++i) {
        float a = (i == cl) ? 1.f : 0.f;
        float nr = (i > 0) ? nrow[i] : 0.f;
        if (i > 0) asm volatile("" : "+v"(nr) : "v"(tt[i - 1]));
#pragma unroll
        for (int j = 0; j < i; ++j)
          a -= __builtin_bit_cast(float, __builtin_amdgcn_readlane(__builtin_bit_cast(int, nr), j)) * tt[j];
        tt[i] = a;
      }
      if (lane < 32) {
#pragma unroll
        for (int i = 0; i < 32; ++i) Tf[(base + i) * 68 + base + cl] = tt[i];
      }
    } else if (wid == 2) {
      float* vec = (float*)(rec + 16384 + 8192 + 6144);
      vec[lane] = __expf(gcs[lane]);
      vec[64 + lane] = __expf(glast - gcs[lane]);
      if (lane == 0) vec[128] = __expf(glast);
    }
    __syncthreads();
    {
      const int i = tid >> 3, c4 = (tid & 7) * 4;
      float x0 = 0.f, x1 = 0.f, x2 = 0.f, x3 = 0.f;
#pragma unroll 8
      for (int j = 0; j < 32; ++j) {
        const float n = Ns[(32 + i) * 68 + j];
        const float4 t = *(const float4*)(Tf + j * 68 + c4);
        x0 += n * t.x; x1 += n * t.y; x2 += n * t.z; x3 += n * t.w;
      }
      *(float4*)(Xf + i * 36 + c4) = make_float4(x0, x1, x2, x3);
    }
    __syncthreads();
    {
      const int i = tid >> 3, c4 = (tid & 7) * 4;
      float y0 = 0.f, y1 = 0.f, y2 = 0.f, y3 = 0.f;
#pragma unroll 8
      for (int k = 0; k < 32; ++k) {
        const float t = (k <= i) ? Tf[(32 + i) * 68 + 32 + k] : 0.f;
        const float4 x = *(const float4*)(Xf + k * 36 + c4);
        y0 += t * x.x; y1 += t * x.y; y2 += t * x.z; y3 += t * x.w;
      }
      *(float4*)(Tf + (32 + i) * 68 + c4) = make_float4(-y0, -y1, -y2, -y3);
      *(float4*)(Tf + i * 68 + 32 + c4) = make_float4(0.f, 0.f, 0.f, 0.f);
    }
    __syncthreads();
    {
      const int i = tid >> 2, c0 = (tid & 3) * 16;
      const int pi = d ? 63 - i : i;
#pragma unroll
      for (int e = 0; e < 16; ++e) {
        const int c = c0 + e, pc = d ? 63 - c : c;
        const float v = Tf[i * 68 + c] * bts[pc];
        Tbs[pi * 72 + pc] = (hf)v;
        Tws[pi * 72 + pc] = (hf)(v * __expf(gcs[pc]));
      }
    }
    __syncthreads();
#pragma unroll
    for (int k = 0; k < 2; ++k) {
      int q = tid + 256 * k;
      int r = q >> 3, c8 = q & 7;
      *(uint4*)(rec + 16384 + (size_t)(r * 64 + c8 * 8) * 2) = *(const uint4*)(Tbs + r * 72 + c8 * 8);
    }
    {
      const int dt = wid;
      h8 fa[4];
#pragma unroll
      for (int su = 0; su < 4; ++su) fa[su] = *(const h8*)(knt + (size_t)(dt * 32 + l31) * 64 + su * 16 + hh * 8);
#pragma unroll
      for (int jt = 0; jt < 2; ++jt) {
        f16v a;
#pragma unroll
        for (int r = 0; r < 16; ++r) a[r] = 0.f;
#pragma unroll
        for (int su = 0; su < 4; ++su) {
          h8 fb = *(const h8*)(Tws + (jt * 32 + l31) * 72 + su * 16 + hh * 8);
          a = mfma16(fa[su], fb, a);
        }
        h8 f0, f1;
#pragma unroll
        for (int r = 0; r < 8; ++r) { f0[r] = (hf)(-a[r]); f1[r] = (hf)(-a[8 + r]); }
        hf* dst = (hf*)rec;
        *(h8*)(dst + (((dt * 2 + jt) * 2 + 0) * 64 + lane) * 8) = f0;
        *(h8*)(dst + (((dt * 2 + jt) * 2 + 1) * 64 + lane) * 8) = f1;
      }
    }
    __syncthreads();
  }
}

DI void phase_scan(const Params& p, char* ldsc) {
  size_t wsz_ = 0;
  asm volatile("" : "+s"(wsz_));
  char* ws = p.ws + wsz_;
  const int tid = tidx(), lane = tid & 63, wid = tid >> 6, hh = lane >> 5, l31 = lane & 31;
  const int rw = wid & 1;
  const bool roleB = wid >= 2;
  hf* wS = (hf*)ldsc;
  hf* TbS = wS + 8192;
  hf* qS = TbS + 64 * 64;
  hf* ktS = qS + 64 * 128;
  hf* qkS = ktS + 128 * 64;
  float* vecS = (float*)(qkS + 3072);
  hf* VfS = (hf*)(vecS + 256);
  hf* SfS = VfS + 4 * 64 * 8;
  for (int it = blockIdx.x; it < 128; it += gridDim.x) {
    const int h = it >> 4, d = (it >> 3) & 1, dv8 = it & 7;
    const int dv = dv8 * 32 + l31;
    const char* recb = ws + OFF_REC + (size_t)((h * 2 + d) * NSTEP) * REC_BYTES;
    hf* O = (hf*)(ws + (d ? OFF_O1 : OFF_O0));
    f16v Sd;
#pragma unroll
    for (int r = 0; r < 16; ++r) Sd[r] = 0.f;
    {
      h8 z;
#pragma unroll
      for (int j = 0; j < 8; ++j) z[j] = (hf)0.f;
      *(h8*)(SfS + ((wid * 2 + 0) * 64 + lane) * 8) = z;
      *(h8*)(SfS + ((wid * 2 + 1) * 64 + lane) * 8) = z;
    }
    h8 vt[4];
    const int wid_s = __builtin_amdgcn_readfirstlane(wid);
    auto dma = [&](const void* src, char* dstbase, int L) {
      __builtin_amdgcn_global_load_lds((const unsigned*)src, (unsigned*)(dstbase + (size_t)(L - tid + wid_s * 64) * 16), 16, 0, 0);
    };
    const int offT = (tid >> 3) * 128 + (((tid & 7) ^ ((tid >> 4) & 7)) * 16);
    const int offQ = (tid >> 4) * 256 + (((tid & 15) ^ ((tid >> 4) & 15)) * 16);
    auto issueG1 = [&](int s) {
      bool isctx; int T, t0;
      step_geom(s, d, isctx, T, t0);
      const char* rec = recb + (size_t)s * REC_BYTES;
      const char* qn = (const char*)((const hf*)(ws + OFF_QN) + (isctx ? (size_t)8 * SEQ * 128 : 0) + ((size_t)h * T + t0) * 128);
#pragma unroll
      for (int k = 0; k < 4; ++k) dma(rec + tid * 16 + k * 4096, (char*)wS, tid + 256 * k);
#pragma unroll
      for (int k = 0; k < 2; ++k) dma(rec + 16384 + offT + k * 4096, (char*)TbS, tid + 256 * k);
#pragma unroll
      for (int k = 0; k < 4; ++k) dma(qn + offQ + k * 4096, (char*)qS, tid + 256 * k);
    };
    auto issueG2 = [&](int s) {
      const char* rec = recb + (size_t)s * REC_BYTES;
      const char* knt = (const char*)((const hf*)(ws + OFF_KNT) + ((size_t)(h * 132 + step_chunk(s, d)) * 128) * 64);
#pragma unroll
      for (int k = 0; k < 4; ++k) dma(knt + offT + k * 4096, (char*)ktS, tid + 256 * k);
      dma(rec + 24576 + tid * 16, (char*)qkS, tid);
      if (tid < 192) dma(rec + 24576 + (tid + 256) * 16, (char*)qkS, tid + 256);
    };
    auto loadV = [&](int s) {
      const hf* vtt = (const hf*)(ws + OFF_VTT) + ((size_t)(h * 132 + step_chunk(s, d)) * 256 + dv) * 64;
#pragma unroll
      for (int su = 0; su < 4; ++su) vt[su] = *(const h8*)(vtt + su * 16 + hh * 8);
    };
    issueG1(0);
    if (!roleB) loadV(0);
    __syncthreads();
#pragma unroll 1
    for (int s = 0; s < NSTEP; ++s) {
      bool isctx; int T, t0;
      step_geom(s, d, isctx, T, t0);
      issueG2(s);
      h8 vf[4];
      f16v ao;
#pragma unroll
      for (int r = 0; r < 16; ++r) ao[r] = 0.f;
      if (!roleB) {
        auto ldA = [&](int i) -> h8 {
          if (i < 4) return *(const h8*)(TbS + (rw * 32 + l31) * 64 + (((i * 2 + hh) ^ ((l31 >> 1) & 7)) * 8));
          const int dt = (i - 4) >> 1, sp = (i - 4) & 1;
          return *(const h8*)(wS + (((dt * 2 + rw) * 2 + sp) * 64 + lane) * 8);
        };
        h8 c0 = ldA(0);
#pragma unroll
        for (int i = 0; i < 12; ++i) {
          h8 n0;
          if (i + 1 < 12) n0 = ldA(i + 1);
          __builtin_amdgcn_sched_barrier(0);
          h8 bf;
          if (i < 4) bf = vt[i];
          else bf = *(const h8*)(SfS + ((i - 4) * 64 + lane) * 8);
          ao = mfma16(c0, bf, ao);
          if (i == 3 && s + 1 < NSTEP) loadV(s + 1);
          __builtin_amdgcn_sched_barrier(0);
          if (i + 1 < 12) c0 = n0;
        }
#pragma unroll
        for (int sp = 0; sp < 2; ++sp) *(h8*)(VfS + ((rw * 2 + sp) * 64 + lane) * 8) = cvt8(ao, sp);
      } else if (!isctx) {
        auto ldQ = [&](int i) -> h8 {
          const hf* qrow = qS + (rw * 32 + l31) * 128 + hh * 4;
          h4 lo = *(const h4*)(qrow + (((2 * i) ^ (l31 & 15)) * 8)), hi = *(const h4*)(qrow + (((2 * i + 1) ^ (l31 & 15)) * 8));
          return __builtin_shufflevector(lo, hi, 0, 1, 2, 3, 4, 5, 6, 7);
        };
        h8 q0 = ldQ(0);
#pragma unroll
        for (int i = 0; i < 8; ++i) {
          h8 n0;
          if (i + 1 < 8) n0 = ldQ(i + 1);
          __builtin_amdgcn_sched_barrier(0);
          ao = mfma16(*(const h8*)(SfS + (i * 64 + lane) * 8), q0, ao);
          __builtin_amdgcn_sched_barrier(0);
          if (i + 1 < 8) q0 = n0;
        }
      }
      __syncthreads();
      if (s + 1 < NSTEP) issueG1(s + 1);
      __builtin_amdgcn_sched_barrier(0);
#pragma unroll
      for (int f = 0; f < 4; ++f) vf[f] = *(const h8*)(VfS + (f * 64 + lane) * 8);
      if (roleB && !isctx) {
        const float egi = vecS[rw * 32 + l31];
#pragma unroll
        for (int r = 0; r < 16; ++r) ao[r] *= egi;
#pragma unroll
        for (int jt = 0; jt < 2; ++jt) {
          int slot = (jt == rw) ? jt : ((d ? (jt > rw) : (jt < rw)) ? 2 : -1);
          if (slot >= 0) {
#pragma unroll
            for (int sp = 0; sp < 2; ++sp) {
              h8 fk = *(const h8*)(qkS + ((slot * 2 + sp) * 64 + lane) * 8);
              ao = mfma16(vf[jt * 2 + sp], fk, ao);
            }
          }
        }
        hf* dst = O + (size_t)(t0 + rw * 32 + l31) * 2048 + h * 256 + dv8 * 32 + 4 * hh;
#pragma unroll
        for (int q = 0; q < 4; ++q) *(h4*)(dst + 8 * q) = mk4(ao[4 * q], ao[4 * q + 1], ao[4 * q + 2], ao[4 * q + 3]);
      }
      __builtin_amdgcn_sched_barrier(0);
      {
        const float egl = vecS[128];
        h8 vk[4];
#pragma unroll
        for (int jt = 0; jt < 2; ++jt)
#pragma unroll
          for (int sp = 0; sp < 2; ++sp) {
            h8 f;
#pragma unroll
            for (int j = 0; j < 8; ++j) f[j] = (hf)((float)vf[jt * 2 + sp][j] * vecS[64 + jt * 32 + rowmap(8 * sp + j, hh)]);
            vk[jt * 2 + sp] = f;
          }
#pragma unroll
        for (int r = 0; r < 16; ++r) Sd[r] *= egl;
        {
          const hf* krow = ktS + (wid * 32 + l31) * 64 + hh * 4;
          const int ksw = (l31 >> 1) & 7;
#pragma unroll
          for (int js = 0; js < 4; ++js) {
            h4 lo = *(const h4*)(krow + (((2 * js) ^ ksw) * 8)), hi = *(const h4*)(krow + (((2 * js + 1) ^ ksw) * 8));
            h8 fk = __builtin_shufflevector(lo, hi, 0, 1, 2, 3, 4, 5, 6, 7);
            Sd = mfma16(fk, vk[js], Sd);
          }
          *(h8*)(SfS + ((wid * 2 + 0) * 64 + lane) * 8) = cvt8(Sd, 0);
          *(h8*)(SfS + ((wid * 2 + 1) * 64 + lane) * 8) = cvt8(Sd, 1);
        }
      }
      __syncthreads();
    }
  }
}

DI void phase_onorm(const Params& p) {
  size_t wsz_ = 0;
  asm volatile("" : "+s"(wsz_));
  char* ws = p.ws + wsz_;
  const int tid = tidx(), lane = tid & 63, wid = tid >> 6;
  const hf* O0 = (const hf*)(ws + OFF_O0);
  const hf* O1 = (const hf*)(ws + OFF_O1);
  hf* sz = (hf*)(ws + OFF_SZ1);
  for (int it = blockIdx.x; it < SEQ / 4; it += gridDim.x) {
    const int row = it * 4 + wid;
#pragma unroll
    for (int k = 0; k < 4; ++k) {
      const int e = k * 512 + lane * 8;
      h8 o = *(const h8*)(O0 + (size_t)row * 2048 + e);
      h8 o1 = *(const h8*)(O1 + (size_t)row * 2048 + e);
      float v[8], ss = 0.f;
#pragma unroll
      for (int j = 0; j < 8; ++j) { v[j] = (float)o[j] + (float)o1[j]; ss += v[j] * v[j]; }
#pragma unroll
      for (int m = 1; m <= 16; m <<= 1) ss += __shfl_xor(ss, m);
      const float rstd = rsqrtf(ss * (1.f / 256.f) + EPS);
      const int dvv = e & 255;
      float4 g0 = *(const float4*)(p.dn_norm_g + dvv), g1 = *(const float4*)(p.dn_norm_g + dvv + 4);
      float gg[8] = {g0.x, g0.y, g0.z, g0.w, g1.x, g1.y, g1.z, g1.w};
      h8 z = *(const h8*)(sz + (size_t)row * 2048 + e);
      h8 r;
#pragma unroll
      for (int j = 0; j < 8; ++j) r[j] = (hf)((float)(hf)(v[j] * rstd * gg[j]) * (float)z[j]);
      *(h8*)(sz + (size_t)row * 2048 + e) = r;
    }
  }
}

DI void phase_final(const Params& p, int b) {
  const int tid = tidx(), lane = tid & 63, wid = tid >> 6;
  for (int it = blockIdx.x; it < SEQ / 4; it += gridDim.x) {
    float* row = p.out + ((size_t)b * SEQ + it * 4 + wid) * D;
    float4 v[4];
    float ss = 0.f;
#pragma unroll
    for (int k = 0; k < 4; ++k) {
      v[k] = *(const float4*)(row + k * 256 + lane * 4);
      ss += v[k].x * v[k].x + v[k].y * v[k].y + v[k].z * v[k].z + v[k].w * v[k].w;
    }
#pragma unroll
    for (int o = 32; o >= 1; o >>= 1) ss += __shfl_xor(ss, o);
    const float rstd = rsqrtf(ss * (1.f / 1024.f) + EPS);
#pragma unroll
    for (int k = 0; k < 4; ++k) {
      float4 g = *(const float4*)(p.final_g + k * 256 + lane * 4);
      *(float4*)(row + k * 256 + lane * 4) = make_float4(v[k].x * rstd * g.x, v[k].y * rstd * g.y, v[k].z * rstd * g.z, v[k].w * rstd * g.w);
    }
  }
}


#define XB_TMO      128
#define XB_XCNT(j)  (256  + 64 * (j))
#define XB_XSUB(j)  (1280 + 64 * (j))
#define XB_XGEN(j)  (2304 + 64 * (j))
#define XB_TOP      3328
#define XB_TOPGEN   3392
#define XCD_BAR_WORDS 3456
#define XB_SPIN_CAP (1u << 18)
#define LAS __attribute__((address_space(3)))
DI unsigned xb_ld(unsigned* p) { return __hip_atomic_load(p, __ATOMIC_RELAXED, __HIP_MEMORY_SCOPE_AGENT); }
DI unsigned xb_add(unsigned* p, unsigned v) { return __hip_atomic_fetch_add(p, v, __ATOMIC_RELAXED, __HIP_MEMORY_SCOPE_AGENT); }
DI unsigned xb_xcc_id() { return (unsigned)__builtin_amdgcn_s_getreg((3 << 11) | 20) & 0xFu; }
#define XB_SPIN(cond, bar) do { unsigned _sp = 0; while (cond) { __builtin_amdgcn_s_sleep(1); \
    if ((++_sp & 255u) == 0u) { if (xb_ld(&(bar)[XB_TMO])) break; if (_sp > XB_SPIN_CAP) { atomicAdd(&(bar)[XB_TMO], 1u); break; } } } } while (0)
struct XcdBarrier { unsigned* bar; unsigned x; volatile LAS unsigned* st; };
DI XcdBarrier xcd_barrier_post(unsigned* bar, volatile LAS unsigned* st) {
  XcdBarrier b; b.bar = bar; b.x = xb_xcc_id(); b.st = st;
  if (threadIdx.x == 0) (void)xb_add(&bar[XB_XCNT(b.x)], 1u);
  return b;
}
DI void xcd_barrier_complete(unsigned* bar, unsigned x, unsigned& nloc, unsigned& nx) {
  const unsigned G = gridDim.x * gridDim.y * gridDim.z;
  unsigned sum, cnt, mine, sp = 0u;
  for (;;) {
    sum = 0u; cnt = 0u; mine = 0u;
#pragma unroll
    for (unsigned j = 0; j < 16; ++j) { const unsigned c = xb_ld(&bar[XB_XCNT(j)]); sum += c; cnt += (c > 0u) ? 1u : 0u; mine = (j == x) ? c : mine; }
    if (sum == G) break;
    __builtin_amdgcn_s_sleep(1);
    if ((++sp & 255u) == 0u) { if (xb_ld(&bar[XB_TMO])) break; if (sp > XB_SPIN_CAP) { atomicAdd(&bar[XB_TMO], 1u); break; } }
  }
  nloc = mine > 0u ? mine : 1u; nx = cnt > 0u ? cnt : 1u;
}
DI void xcd_barrier(const XcdBarrier& b) {
  asm volatile("s_waitcnt vmcnt(0)" ::: "memory");
  __syncthreads();
  if (threadIdx.x == 0) {
    unsigned* bar = b.bar;
    __builtin_amdgcn_s_waitcnt(0);
    unsigned nloc = b.st[0], nx = b.st[1];
    if (nloc == 0u) { xcd_barrier_complete(bar, b.x, nloc, nx); b.st[0] = nloc; b.st[1] = nx; }
    const unsigned old = xb_add(&bar[XB_XSUB(b.x)], 1u);
    const unsigned gen = old / nloc;
    if (old + 1u == (gen + 1u) * nloc) {
      __builtin_amdgcn_fence(__ATOMIC_RELEASE, "agent");
      asm volatile("s_waitcnt vmcnt(0)" ::: "memory");
      const unsigned og = xb_add(&bar[XB_TOP], 1u);
      const unsigned tg = og / nx;
      if (og + 1u == (tg + 1u) * nx) xb_add(&bar[XB_TOPGEN], 1u);
      else XB_SPIN(xb_ld(&bar[XB_TOPGEN]) == tg, bar);
      __builtin_amdgcn_fence(__ATOMIC_ACQUIRE, "agent");
      xb_add(&bar[XB_XGEN(b.x)], 1u);
      asm volatile("s_waitcnt vmcnt(0)" ::: "memory");
    } else {
      XB_SPIN(xb_ld(&bar[XB_XGEN(b.x)]) == gen, bar);
      __builtin_amdgcn_fence(__ATOMIC_ACQUIRE, "agent");
      asm volatile("s_waitcnt vmcnt(0)" ::: "memory");
    }
  }
  __syncthreads();
}

#define PROBE_DUP (-1)
constexpr int NPHASE = 1 + 2 * (14 + (PROBE_DUP >= 0 ? 1 : 0));
#define PROBE_REP_MASK 0
#define PROBE_REP_N 2
#define PROBE_XSYNC 0

__global__ void __launch_bounds__(256, 2) fwd_megakernel(Params p) {
  extern __shared__ __attribute__((aligned(16))) char lds[];
  cg::grid_group grid = cg::this_grid();
  volatile LAS unsigned* xbst = (volatile LAS unsigned*)(lds + LDS_BYTES - 16);
  if (threadIdx.x == 0) { xbst[0] = 0u; xbst[1] = 0u; }
  __syncthreads();
  XcdBarrier xb = xcd_barrier_post((unsigned*)(p.ws + OFF_BAR), xbst);
  for (int ph = p.ph_lo; ph < p.ph_hi; ++ph) {
    if (ph > p.ph_lo) {
      if (p.ph_lo < 0) grid.sync();
      xcd_barrier(xb);
      for (int xs = 0; xs < PROBE_XSYNC; ++xs) xcd_barrier(xb);
    }
#ifdef ONLY
    const int b = 0, q = ONLY; if (ONLY < 0) { phase_prep(p, lds, 0); continue; }
#else
    if (ph == 0) { phase_prep(p, lds, 0); continue; }
    constexpr int NPER = 14 + (PROBE_DUP >= 0 ? 1 : 0);
    const int b = (ph - 1) / NPER, e_ = (ph - 1) % NPER;
    const int q = (PROBE_DUP >= 0 && e_ > PROBE_DUP) ? e_ - 1 : e_;
#endif
    for (int rep = 0; rep < ((PROBE_REP_MASK >> q) & 1 ? PROBE_REP_N : 1); ++rep)
    switch (q) {
      case 0: phase_normmod(p, b, 0); phase_prep(p, lds, 1); break;
      case 1: phase_gemm1(p, (hf*)lds); break;
      case 2: phase_stageA(p, (hf*)lds); break;
      case 3: phase_stageB(p, (hf*)lds); break;
      case 4: phase_group(p, (hf*)lds); break;
      case 5: phase_outproj(p, b, 0, (hf*)lds); break;
      case 6: phase_normmod(p, b, 1); break;
      case 7: phase_inproj1(p, (hf*)lds); break;
      case 8: phase_conv(p, lds); break;
      case 9: phase_dprep(p, lds); break;
      case 10: phase_scan(p, lds); break;
      case 11: phase_onorm(p); break;
      case 12: phase_outproj(p, b, 1, (hf*)lds); break;
      case 13: phase_final(p, b); break;
    }
  }
}

extern "C" void kernel_launch(void* const* d_in, const int* in_sizes, int n_in, void* d_out, int out_size, void* d_ws,
                              size_t ws_size, hipStream_t stream) {
  static int grid_blocks = 0;
  if (!grid_blocks) {
    int dev = 0, cus = 0, per_cu = 0;
    hipGetDevice(&dev);
    hipDeviceGetAttribute(&cus, hipDeviceAttributeMultiprocessorCount, dev);
    hipFuncSetAttribute((const void*)fwd_megakernel, hipFuncAttributeMaxDynamicSharedMemorySize, LDS_BYTES);
    hipOccupancyMaxActiveBlocksPerMultiprocessor(&per_cu, (const void*)fwd_megakernel, 256, LDS_BYTES);
    if (per_cu < 1) per_cu = 1;
    if (per_cu > 2) per_cu = 2;
    grid_blocks = cus * per_cu;
    if (ws_size < WS_NEED) fprintf(stderr, "workspace too small: %zu < %zu\n", ws_size, (size_t)WS_NEED);
  }
  Params p{};
  const float** f = (const float**)&p;
  for (int i = 0; i < 17; ++i) f[i] = (const float*)d_in[i];
  p.out = (float*)d_out;
  p.ws = (char*)d_ws;
  p.ph_lo = 0;
  p.ph_hi = NPHASE;
  void* args[] = {&p};
  (void)hipMemsetAsync((char*)d_ws + OFF_BAR, 0, XCD_BAR_WORDS * 4, stream);
  hipError_t e = hipLaunchCooperativeKernel((const void*)fwd_megakernel, dim3(grid_blocks), dim3(256), args, LDS_BYTES, stream);
  if (e != hipSuccess) fprintf(stderr, "cooperative launch failed: %s (grid %d)\n", hipGetErrorString(e), grid_blocks);
}
```

```cpp
#include <hip/hip_runtime.h>
#include <hip/hip_cooperative_groups.h>
#include <cstdio>
namespace cg = cooperative_groups;

typedef _Float16 hf;
typedef hf h8 __attribute__((ext_vector_type(8)));
typedef hf h4 __attribute__((ext_vector_type(4)));
typedef hf h2 __attribute__((ext_vector_type(2)));
typedef float f16v __attribute__((ext_vector_type(16)));

#define DI __device__ __forceinline__

constexpr int D = 1024, SEQ = 8192, CTXL = 256, ROWS = SEQ + CTXL;
constexpr float EPS = 1e-6f;
constexpr size_t MiB = 1ull << 20;
constexpr size_t OFF_WDNIN = 0;
constexpr size_t OFF_WDNOUT = 13 * MiB;
constexpr size_t OFF_TW1 = 17 * MiB;
constexpr size_t OFF_TW2 = OFF_TW1 + 65536;
constexpr size_t OFF_T256 = OFF_TW2 + 32768;
constexpr size_t OFF_TWID = OFF_T256 + 262144;
constexpr size_t OFF_MOD = OFF_TWID + 65536;
constexpr size_t OFF_HCTX = 18 * MiB;
constexpr size_t OFF_AB = 19 * MiB;
constexpr size_t OFF_BAR = 21 * MiB;
constexpr size_t ARENA = 22 * MiB;
constexpr size_t OFF_WFNIN = ARENA + 0;
constexpr size_t OFF_WFNOUT = ARENA + 8 * MiB;
constexpr size_t OFF_WG = 252 * MiB;
constexpr size_t OFF_A0 = ARENA + 14 * MiB;
constexpr size_t OFF_YTL = ARENA + 31 * MiB;
constexpr size_t OFF_YTC = ARENA + 63 * MiB;
constexpr size_t OFF_SZ0 = ARENA + 64 * MiB;
constexpr size_t OFF_ZT = ARENA + 97 * MiB;
constexpr size_t OFF_VT = ARENA + 161 * MiB;
constexpr size_t OFF_QN = ARENA + 0;
constexpr size_t OFF_SZ1 = ARENA + 17 * MiB;
constexpr size_t OFF_REC = ARENA + 50 * MiB;
constexpr size_t OFF_KNT = ARENA + 116 * MiB;
constexpr size_t OFF_VTT = ARENA + 133 * MiB;
constexpr size_t OFF_O0 = ARENA + 166 * MiB;
constexpr size_t OFF_O1 = ARENA + 198 * MiB;
constexpr size_t OFF_KN = ARENA + 198 * MiB;
constexpr size_t WS_NEED = 254 * MiB;
constexpr int REC_BYTES = 31744;
constexpr int NSTEP = 132;
constexpr int LDS_BYTES = 78848;

struct Params {
  const float *x, *c, *ctx, *c_ctx, *mod_w, *mod_b, *norm_g, *final_g, *fn_w_in, *fn_w_grp, *fn_w_out,
      *dn_w_in, *dn_conv, *dn_a_log, *dn_dt_bias, *dn_norm_g, *dn_w_out;
  float* out;
  char* ws;
  int ph_lo, ph_hi;
};

DI int tidx() {
  int t = threadIdx.x;
  asm volatile("" : "+v"(t));
  return t;
}
DI float silu_f(float v) { return v / (1.f + __expf(-v)); }
DI f16v mfma16(h8 a, h8 b, f16v c) { return __builtin_amdgcn_mfma_f32_32x32x16_f16(a, b, c, 0, 0, 0); }
DI uint4 ldg4(const void* p) { return *(const uint4*)p; }
DI int rowmap(int r, int hh) { return 8 * (r >> 2) + 4 * hh + (r & 3); }
DI h8 cvt8(const f16v& a, int s) {
  h8 r;
#pragma unroll
  for (int j = 0; j < 8; ++j) r[j] = (hf)a[8 * s + j];
  return r;
}

constexpr int LDP = 40;
template <bool SWAP, class AF, class BF>
DI void gemm_main(hf* lds, int K, AF arow, BF brow, f16v (&acc)[2][2]) {
  const int tid = tidx(), lane = tid & 63, wid = tid >> 6;
  const int wr = wid >> 1, wc = wid & 1;
  hf* sA = lds;
  hf* sB = lds + 2 * 128 * LDP;
  const int lr = tid >> 2, kc = (tid & 3) * 8;
  const hf* pa0 = arow(lr) + kc;
  const hf* pa1 = arow(lr + 64) + kc;
  const hf* pb0 = brow(lr) + kc;
  const hf* pb1 = brow(lr + 64) + kc;
#pragma unroll
  for (int i = 0; i < 2; ++i)
#pragma unroll
    for (int j = 0; j < 2; ++j)
#pragma unroll
      for (int r = 0; r < 16; ++r) acc[i][j][r] = 0.f;
  uint4 ra0 = ldg4(pa0), ra1 = ldg4(pa1), rb0 = ldg4(pb0), rb1 = ldg4(pb1);
  const int wo0 = lr * LDP + kc, wo1 = (lr + 64) * LDP + kc;
  *(uint4*)(sA + wo0) = ra0;
  *(uint4*)(sA + wo1) = ra1;
  *(uint4*)(sB + wo0) = rb0;
  *(uint4*)(sB + wo1) = rb1;
  __syncthreads();
  const int nk = K >> 5;
  const int aoff = (wr * 64 + (lane & 31)) * LDP + (lane >> 5) * 8;
  const int boff = (wc * 64 + (lane & 31)) * LDP + (lane >> 5) * 8;
  for (int kt = 0; kt < nk; ++kt) {
    const int cur = kt & 1;
    const bool more = (kt + 1 < nk);
    if (more) {
      const int ko = (kt + 1) * 32;
      ra0 = ldg4(pa0 + ko);
      ra1 = ldg4(pa1 + ko);
      rb0 = ldg4(pb0 + ko);
      rb1 = ldg4(pb1 + ko);
    }
    const hf* cA = sA + cur * 128 * LDP;
    const hf* cB = sB + cur * 128 * LDP;
#pragma unroll
    for (int ks = 0; ks < 2; ++ks) {
      h8 a0 = *(const h8*)(cA + aoff + ks * 16), a1 = *(const h8*)(cA + aoff + 32 * LDP + ks * 16);
      h8 b0 = *(const h8*)(cB + boff + ks * 16), b1 = *(const h8*)(cB + boff + 32 * LDP + ks * 16);
      if (SWAP) {
        acc[0][0] = mfma16(b0, a0, acc[0][0]);
        acc[0][1] = mfma16(b1, a0, acc[0][1]);
        acc[1][0] = mfma16(b0, a1, acc[1][0]);
        acc[1][1] = mfma16(b1, a1, acc[1][1]);
      } else {
        acc[0][0] = mfma16(a0, b0, acc[0][0]);
        acc[0][1] = mfma16(a0, b1, acc[0][1]);
        acc[1][0] = mfma16(a1, b0, acc[1][0]);
        acc[1][1] = mfma16(a1, b1, acc[1][1]);
      }
    }
    if (more) {
      hf* nA = sA + (cur ^ 1) * 128 * LDP;
      hf* nB = sB + (cur ^ 1) * 128 * LDP;
      *(uint4*)(nA + wo0) = ra0;
      *(uint4*)(nA + wo1) = ra1;
      *(uint4*)(nB + wo0) = rb0;
      *(uint4*)(nB + wo1) = rb1;
    }
    __syncthreads();
  }
}
template <bool SWAP, class AF, class BF>
DI void gemm_main2(hf* lds, int K, AF arow, BF brow, f16v (&acc)[2][2]) {
  const int tid = tidx(), lane = tid & 63, wid = tid >> 6;
  const int wr = wid >> 1, wc = wid & 1;
  char* ldsb = (char*)lds;
  const int rsub = lane >> 2, cp = lane & 3;
  const int r0 = (wid * 2) * 16 + rsub, r1 = (wid * 2 + 1) * 16 + rsub;
  const int cl0 = (cp ^ ((r0 >> 2) & 3)) * 8, cl1 = (cp ^ ((r1 >> 2) & 3)) * 8;
  const hf* pa0 = arow(r0) + cl0;
  const hf* pa1 = arow(r1) + cl1;
  const hf* pb0 = brow(r0) + cl0;
  const hf* pb1 = brow(r1) + cl1;
  const int dA0 = __builtin_amdgcn_readfirstlane(wid) * 2048, dA1 = dA0 + 1024;
#pragma unroll
  for (int i = 0; i < 2; ++i)
#pragma unroll
    for (int j = 0; j < 2; ++j)
#pragma unroll
      for (int r = 0; r < 16; ++r) acc[i][j][r] = 0.f;
  auto issue = [&](int kt) {
    char* st = ldsb + (kt & 3) * 16384;
    const int ko = kt * 32;
    __builtin_amdgcn_global_load_lds((const unsigned*)(pa0 + ko), (unsigned*)(st + dA0), 16, 0, 0);
    __builtin_amdgcn_global_load_lds((const unsigned*)(pa1 + ko), (unsigned*)(st + dA1), 16, 0, 0);
    __builtin_amdgcn_global_load_lds((const unsigned*)(pb0 + ko), (unsigned*)(st + 8192 + dA0), 16, 0, 0);
    __builtin_amdgcn_global_load_lds((const unsigned*)(pb1 + ko), (unsigned*)(st + 8192 + dA1), 16, 0, 0);
  };
  const int nk = K >> 5;
  issue(0);
  issue(1);
  issue(2);
  const int l31 = lane & 31, hh = lane >> 5, swz = (l31 >> 2) & 3;
  const int fo0 = ((0 + hh) ^ swz) * 16, fo1 = ((2 + hh) ^ swz) * 16;
  const int arb = (wr * 64 + l31) * 64, brb = 8192 + (wc * 64 + l31) * 64;
  for (int kt = 0; kt < nk; ++kt) {
    if (kt + 2 < nk) asm volatile("s_waitcnt vmcnt(8) lgkmcnt(0)" ::: "memory");
    else if (kt + 1 < nk) asm volatile("s_waitcnt vmcnt(4) lgkmcnt(0)" ::: "memory");
    else asm volatile("s_waitcnt vmcnt(0)" ::: "memory");
    __builtin_amdgcn_s_barrier();
    const char* st = ldsb + (kt & 3) * 16384;
#pragma unroll
    for (int ks = 0; ks < 2; ++ks) {
      const int fo = ks ? fo1 : fo0;
      if (ks == 1 && kt + 3 < nk) issue(kt + 3);
      h8 a0 = *(const h8*)(st + arb + fo), a1 = *(const h8*)(st + arb + 2048 + fo);
      h8 b0 = *(const h8*)(st + brb + fo), b1 = *(const h8*)(st + brb + 2048 + fo);
      if (SWAP) {
        acc[0][0] = mfma16(b0, a0, acc[0][0]);
        acc[0][1] = mfma16(b1, a0, acc[0][1]);
        acc[1][0] = mfma16(b0, a1, acc[1][0]);
        acc[1][1] = mfma16(b1, a1, acc[1][1]);
      } else {
        acc[0][0] = mfma16(a0, b0, acc[0][0]);
        acc[0][1] = mfma16(a0, b1, acc[0][1]);
        acc[1][0] = mfma16(a1, b0, acc[1][0]);
        acc[1][1] = mfma16(a1, b1, acc[1][1]);
      }
    }
  }
  __builtin_amdgcn_s_barrier();
}
template <bool SWAP, class F>
DI void gemm_epi(f16v (&acc)[2][2], F f) {
  const int tid = tidx(), lane = tid & 63, wid = tid >> 6;
  const int wr = wid >> 1, wc = wid & 1, hh = lane >> 5, l31 = lane & 31;
#pragma unroll
  for (int i = 0; i < 2; ++i)
#pragma unroll
    for (int j = 0; j < 2; ++j)
#pragma unroll
      for (int q = 0; q < 4; ++q) {
        if (SWAP) {
          int m = wr * 64 + i * 32 + l31, n0 = wc * 64 + j * 32 + 8 * q + 4 * hh;
          f(m, n0, acc[i][j][4 * q], acc[i][j][4 * q + 1], acc[i][j][4 * q + 2], acc[i][j][4 * q + 3]);
        } else {
          int m0 = wr * 64 + i * 32 + 8 * q + 4 * hh, n = wc * 64 + j * 32 + l31;
          f(m0, n, acc[i][j][4 * q], acc[i][j][4 * q + 1], acc[i][j][4 * q + 2], acc[i][j][4 * q + 3]);
        }
      }
}
DI h4 mk4(float a, float b, float c, float d) {
  h4 r;
  r[0] = (hf)a; r[1] = (hf)b; r[2] = (hf)c; r[3] = (hf)d;
  return r;
}

DI void transpose_tile(const float* src, int K, int N, hf* dst, int tk, int tn, float* lds) {
  const int tid = tidx();
  const int c4 = (tid & 15) * 4, n = tn * 64 + c4;
#pragma unroll
  for (int i = 0; i < 4; ++i) {
    int k = (tid >> 4) + i * 16;
    float4 v = make_float4(0.f, 0.f, 0.f, 0.f);
    if (n < N) v = *(const float4*)(src + (size_t)(tk * 64 + k) * N + n);
    lds[k * 65 + c4 + 0] = v.x;
    lds[k * 65 + c4 + 1] = v.y;
    lds[k * 65 + c4 + 2] = v.z;
    lds[k * 65 + c4 + 3] = v.w;
  }
  __syncthreads();
#pragma unroll
  for (int i = 0; i < 2; ++i) {
    int q = tid + i * 256;
    int nn = q >> 3, k8 = (q & 7) * 8;
    h8 o;
#pragma unroll
    for (int j = 0; j < 8; ++j) o[j] = (hf)lds[(k8 + j) * 65 + nn];
    *(h8*)(dst + (size_t)(tn * 64 + nn) * K + tk * 64 + k8) = o;
  }
  __syncthreads();
}

DI void phase_prep(const Params& p, char* ldsc, int which) {
  const int tid = tidx();
  float* lds = (float*)ldsc;
  size_t wsz_ = 0;
  asm volatile("" : "+s"(wsz_));
  char* ws = p.ws + wsz_;
  constexpr int N1 = 1024, N2 = 512, N3 = 1568, N4 = 512, N5 = 512, N6 = 736, N7 = 384;
  constexpr int TOT = N1 + N2 + N3 + N4 + N5 + N6 + N7;
  for (int it = blockIdx.x; it < TOT; it += gridDim.x) {
    int i = it;
    {
      const bool l0 = (i < N1 + N2);
      if (l0 != (which == 1)) continue;
    }
    if (i < N1) { transpose_tile(p.fn_w_in, 1024, 4096, (hf*)(ws + OFF_WFNIN), i / 64, i % 64, lds); continue; }
    i -= N1;
    if (i < N2) { transpose_tile(p.fn_w_out, 2048, 1024, (hf*)(ws + OFF_WFNOUT), i / 16, i % 16, lds); continue; }
    i -= N2;
    if (i < N3) { transpose_tile(p.dn_w_in, 1024, 6176, (hf*)(ws + OFF_WDNIN), i / 98, i % 98, lds); continue; }
    i -= N3;
    if (i < N4) { transpose_tile(p.dn_w_out, 2048, 1024, (hf*)(ws + OFF_WDNOUT), i / 16, i % 16, lds); continue; }
    i -= N4;
    if (i < N5) {
      const int g = i >> 6, c0 = (i & 63) * 4, d = tid;
      float sv, cv;
      sincospif((float)tid / 128.f, &sv, &cv);
      lds[tid] = cv;
      lds[256 + tid] = sv;
      __syncthreads();
      float ac[4], as[4];
#pragma unroll
      for (int j = 0; j < 4; ++j) { ac[j] = 0.f; as[j] = 0.f; }
      const float* w = p.fn_w_grp + (size_t)g * 65536 + d;
#pragma unroll 4
      for (int m = 0; m < 256; ++m) {
        float wv = w[m * 256];
#pragma unroll
        for (int j = 0; j < 4; ++j) {
          int idx = (m * (c0 + j)) & 255;
          ac[j] += lds[idx] * wv;
          as[j] += lds[256 + idx] * wv;
        }
      }
      hf* dst = (hf*)(ws + OFF_WG) + (size_t)(g * 256 + d) * 512;
      *(h4*)(dst + c0) = mk4(ac[0] * 0.0625f, ac[1] * 0.0625f, ac[2] * 0.0625f, ac[3] * 0.0625f);
      *(h4*)(dst + 256 + c0) = mk4(as[0] * 0.0625f, as[1] * 0.0625f, as[2] * 0.0625f, as[3] * 0.0625f);
      __syncthreads();
      continue;
    }
    i -= N5;
    if (i < N6) {
      int e = i * 256 + tid;
      if (e < 32768) {
        int n = e >> 7, l1 = e & 127;
        int im = (n >> 5) & 1, k1 = (n >> 6) * 32 + (n & 31);
        float sv, cv;
        sincospif((float)((k1 * l1) & 127) / 64.f, &sv, &cv);
        ((hf*)(ws + OFF_TW1))[e] = (hf)((im ? -sv : cv) * 0.08838834764831845f);
      } else if (e < 32768 + 16384) {
        int e2 = e - 32768;
        int n = e2 >> 7, kk = e2 & 127;
        int im = n >> 6, k2 = n & 63, l2 = kk & 63, hi = kk >> 6;
        float sv, cv;
        sincospif((float)((k2 * l2) & 63) / 32.f, &sv, &cv);
        float v = (im == 0) ? (hi ? sv : cv) : (hi ? cv : -sv);
        ((hf*)(ws + OFF_TW2))[e2] = (hf)(v * 0.125f);
      } else if (e < 32768 + 16384 + 131072) {
        int e2 = e - 49152;
        int n = e2 >> 8, l = e2 & 255;
        int im = n >> 8, k = n & 255;
        float sv, cv;
        sincospif((float)((k * l) & 255) / 128.f, &sv, &cv);
        ((hf*)(ws + OFF_T256))[e2] = (hf)((im ? -sv : cv) * 0.0625f);
      } else if (e < 32768 + 16384 + 131072 + 8192) {
        int j = e - 180224;
        float sv, cv;
        sincospif((float)j / 4096.f, &sv, &cv);
        ((float*)(ws + OFF_TWID))[2 * j] = cv;
        ((float*)(ws + OFF_TWID))[2 * j + 1] = sv;
      }
      continue;
    }
    i -= N6;
    {
      const int q0 = i * 16, layer = q0 / 3072, n = (q0 % 3072) + (tid & 15), ks = tid >> 4;
      for (int e = tid; e < 3072; e += 256) {
        int cond = e >> 10, k = e & 1023;
        float v = cond == 0 ? p.c[k] : (cond == 1 ? p.c[1024 + k] : p.c_ctx[k]);
        lds[e] = silu_f(v);
      }
      __syncthreads();
      float a0 = 0.f, a1 = 0.f, a2 = 0.f;
      const float* w = p.mod_w + (size_t)layer * 1024 * 3072 + n;
#pragma unroll 16
      for (int k = ks * 64; k < ks * 64 + 64; ++k) {
        float wv = w[(size_t)k * 3072];
        a0 += lds[k] * wv;
        a1 += lds[1024 + k] * wv;
        a2 += lds[2048 + k] * wv;
      }
      float* red = lds + 3072;
      red[(ks * 3 + 0) * 16 + (tid & 15)] = a0;
      red[(ks * 3 + 1) * 16 + (tid & 15)] = a1;
      red[(ks * 3 + 2) * 16 + (tid & 15)] = a2;
      __syncthreads();
      if (tid < 48) {
        int cond = tid >> 4, cl = tid & 15;
        float sacc = 0.f;
#pragma unroll
        for (int j = 0; j < 16; ++j) sacc += red[(j * 3 + cond) * 16 + cl];
        int nn = (q0 % 3072) + cl;
        ((float*)(ws + OFF_MOD))[(layer * 3 + cond) * 3072 + nn] = sacc + p.mod_b[layer * 3072 + nn];
      }
      __syncthreads();
    }
  }
}

DI void phase_normmod(const Params& p, int b, int layer) {
  const int tid = tidx(), lane = tid & 63, wid = tid >> 6;
  size_t wsz_ = 0;
  asm volatile("" : "+s"(wsz_));
  char* ws = p.ws + wsz_;
  hf* A = (hf*)(ws + (layer == 0 ? OFF_A0 : OFF_QN));
  const float* modb = (const float*)(ws + OFF_MOD);
  const float* g = p.norm_g + layer * 1024;
  for (int it = blockIdx.x; it < ROWS / 4; it += gridDim.x) {
    const int r = it * 4 + wid;
    const float* src;
    int cond;
    if (r < SEQ) {
      src = (layer == 0 ? p.x : p.out) + ((size_t)b * SEQ + r) * D;
      cond = b;
    } else {
      src = (layer == 0) ? p.ctx + ((size_t)b * CTXL + (r - SEQ)) * D : (const float*)(ws + OFF_HCTX) + (size_t)(r - SEQ) * D;
      cond = 2;
    }
    const float* mb = modb + (layer * 3 + cond) * 3072;
    float4 v[4];
    float ss = 0.f;
#pragma unroll
    for (int k = 0; k < 4; ++k) {
      v[k] = *(const float4*)(src + k * 256 + lane * 4);
      ss += v[k].x * v[k].x + v[k].y * v[k].y + v[k].z * v[k].z + v[k].w * v[k].w;
    }
#pragma unroll
    for (int o = 32; o >= 1; o >>= 1) ss += __shfl_xor(ss, o);
    const float rstd = rsqrtf(ss * (1.f / 1024.f) + EPS);
#pragma unroll
    for (int k = 0; k < 4; ++k) {
      int col = k * 256 + lane * 4;
      float4 gg = *(const float4*)(g + col), sh = *(const float4*)(mb + col), sc = *(const float4*)(mb + 1024 + col);
      h4 o = mk4(v[k].x * rstd * gg.x * (1.f + sc.x) + sh.x, v[k].y * rstd * gg.y * (1.f + sc.y) + sh.y,
                 v[k].z * rstd * gg.z * (1.f + sc.z) + sh.z, v[k].w * rstd * gg.w * (1.f + sc.w) + sh.w);
      *(h4*)(A + (size_t)r * D + col) = o;
      if (layer == 0 && r >= SEQ) *(float4*)((float*)(ws + OFF_HCTX) + (size_t)(r - SEQ) * D + col) = v[k];
    }
  }
}

DI void phase_gemm1(const Params& p, hf* lds) {
  size_t wsz_ = 0;
  asm volatile("" : "+s"(wsz_));
  char* ws = p.ws + wsz_;
  const hf* A = (const hf*)(ws + OFF_A0);
  const hf* W = (const hf*)(ws + OFF_WFNIN);
  hf* ytl = (hf*)(ws + OFF_YTL);
  hf* ytc = (hf*)(ws + OFF_YTC);
  hf* sz = (hf*)(ws + OFF_SZ0);
  for (int t = blockIdx.x; t < 66 * 32; t += gridDim.x) {
    const int mt = t >> 5, nt = t & 31;
    auto arow = [&](int r) -> const hf* {
      int row = (mt < 64) ? (r * 64 + mt) : (SEQ + (mt - 64) * 128 + r);
      return A + (size_t)row * D;
    };
    auto brow = [&](int r) -> const hf* { return W + (size_t)(nt * 128 + r) * D; };
    f16v acc[2][2];
    if (nt < 16) {
      gemm_main2<false>(lds, D, arow, brow, acc);
      gemm_epi<false>(acc, [&](int m0, int n, float a, float b, float c, float d) {
        int col = nt * 128 + n;
        h4 o = mk4(a, b, c, d);
        if (mt < 64) *(h4*)(ytl + ((size_t)col * 64 + mt) * 128 + m0) = o;
        else *(h4*)(ytc + (size_t)col * 256 + (mt - 64) * 128 + m0) = o;
      });
    } else {
      gemm_main2<true>(lds, D, arow, brow, acc);
      gemm_epi<true>(acc, [&](int m, int n0, float a, float b, float c, float d) {
        int row = (mt < 64) ? (m * 64 + mt) : (SEQ + (mt - 64) * 128 + m);
        int col = (nt - 16) * 128 + n0;
        *(h4*)(sz + (size_t)row * 2048 + col) = mk4(silu_f(a), silu_f(b), silu_f(c), silu_f(d));
      });
    }
  }
}

DI void phase_stageA(const Params& p, hf* lds) {
  size_t wsz_ = 0;
  asm volatile("" : "+s"(wsz_));
  char* ws = p.ws + wsz_;
  const hf* ytl = (const hf*)(ws + OFF_YTL);
  const hf* ytc = (const hf*)(ws + OFF_YTC);
  const hf* w1 = (const hf*)(ws + OFF_TW1);
  const hf* w256 = (const hf*)(ws + OFF_T256);
  const float2* tw = (const float2*)(ws + OFF_TWID);
  hf* zt = (hf*)(ws + OFF_ZT);
  hf* vt = (hf*)(ws + OFF_VT);
  const int lane = tidx() & 63, wid = tidx() >> 6, wr = wid >> 1, wc = wid & 1, hh = lane >> 5, l31 = lane & 31;
  for (int t = blockIdx.x; t < 2048 + 64; t += gridDim.x) {
    f16v acc[2][2];
    if (t < 2048) {
      const int mt = t >> 1, nt = t & 1;
      auto arow = [&](int r) -> const hf* { return ytl + (size_t)(mt * 128 + r) * 128; };
      auto brow = [&](int r) -> const hf* { return w1 + (size_t)(nt * 128 + r) * 128; };
      gemm_main2<false>(lds, 128, arow, brow, acc);
      const int k1 = (nt * 2 + wc) * 32 + l31;
#pragma unroll
      for (int i = 0; i < 2; ++i)
#pragma unroll
        for (int q = 0; q < 4; ++q) {
          const int m0 = mt * 128 + wr * 64 + i * 32 + 8 * q + 4 * hh;
          const int col = m0 >> 6, l2 = m0 & 63;
          float zr[4], zi[4];
#pragma unroll
          for (int e = 0; e < 4; ++e) {
            float2 cs = tw[(k1 * (l2 + e)) & 8191];
            float re = acc[i][0][4 * q + e], im = acc[i][1][4 * q + e];
            zr[e] = re * cs.x + im * cs.y;
            zi[e] = im * cs.x - re * cs.y;
          }
          size_t base = (((size_t)k1 * 2048 + col) * 2) * 64 + l2;
          *(h4*)(zt + base) = mk4(zr[0], zr[1], zr[2], zr[3]);
          *(h4*)(zt + base + 64) = mk4(zi[0], zi[1], zi[2], zi[3]);
        }
    } else {
      const int tt = t - 2048, mt = tt >> 2, nt = tt & 3;
      auto arow = [&](int r) -> const hf* { return ytc + (size_t)(mt * 128 + r) * 256; };
      auto brow = [&](int r) -> const hf* { return w256 + (size_t)(nt * 128 + r) * 256; };
      gemm_main2<false>(lds, 256, arow, brow, acc);
      gemm_epi<false>(acc, [&](int m0, int n, float a, float b, float c, float d) {
        int col = mt * 128 + m0, nn = nt * 128 + n;
        int im = nn >> 8, k = nn & 255, g = col >> 8, cc = col & 255;
        *(h4*)(vt + (size_t)(SEQ + k) * 4096 + g * 512 + im * 256 + cc) = mk4(a, b, c, d);
      });
    }
  }
}

DI void phase_stageB(const Params& p, hf* lds) {
  size_t wsz_ = 0;
  asm volatile("" : "+s"(wsz_));
  char* ws = p.ws + wsz_;
  const hf* zt = (const hf*)(ws + OFF_ZT);
  const hf* w2 = (const hf*)(ws + OFF_TW2);
  hf* vt = (hf*)(ws + OFF_VT);
  for (int t = blockIdx.x; t < 2048; t += gridDim.x) {
    f16v acc[2][2];
    auto arow = [&](int r) -> const hf* { return zt + (size_t)(t * 128 + r) * 128; };
    auto brow = [&](int r) -> const hf* { return w2 + (size_t)r * 128; };
    gemm_main2<false>(lds, 128, arow, brow, acc);
    gemm_epi<false>(acc, [&](int m0, int n, float a, float b, float c, float d) {
      int m = t * 128 + m0;
      int k1 = m >> 11, col = m & 2047, im = n >> 6, k2 = n & 63;
      int g = col >> 8, cc = col & 255;
      *(h4*)(vt + (size_t)(k1 + 128 * k2) * 4096 + g * 512 + im * 256 + cc) = mk4(a, b, c, d);
    });
  }
}

DI void phase_group(const Params& p, hf* lds) {
  size_t wsz_ = 0;
  asm volatile("" : "+s"(wsz_));
  char* ws = p.ws + wsz_;
  const hf* vt = (const hf*)(ws + OFF_VT);
  const hf* wg = (const hf*)(ws + OFF_WG);
  hf* sz = (hf*)(ws + OFF_SZ0);
  for (int t = blockIdx.x; t < 66 * 16; t += gridDim.x) {
    const int mt = t >> 4, g = (t >> 1) & 7, nt = t & 1;
    f16v acc[2][2];
    auto arow = [&](int r) -> const hf* { return vt + (size_t)(mt * 128 + r) * 4096 + g * 512; };
    auto brow = [&](int r) -> const hf* { return wg + (size_t)(g * 256 + nt * 128 + r) * 512; };
    gemm_main2<true>(lds, 512, arow, brow, acc);
    gemm_epi<true>(acc, [&](int m, int n0, float a, float b, float c, float d) {
      hf* q = sz + (size_t)(mt * 128 + m) * 2048 + g * 256 + nt * 128 + n0;
      h4 s = *(const h4*)q;
      *(h4*)q = mk4(a * (float)s[0], b * (float)s[1], c * (float)s[2], d * (float)s[3]);
    });
  }
}

DI void phase_outproj(const Params& p, int b, int layer, hf* lds) {
  size_t wsz_ = 0;
  asm volatile("" : "+s"(wsz_));
  char* ws = p.ws + wsz_;
  const hf* A = (const hf*)(ws + (layer == 0 ? OFF_SZ0 : OFF_SZ1));
  const hf* W = (const hf*)(ws + (layer == 0 ? OFF_WFNOUT : OFF_WDNOUT));
  const float* modb = (const float*)(ws + OFF_MOD);
  const int ntile = layer == 0 ? 512 + 128 : 512;
  for (int t = blockIdx.x; t < ntile; t += gridDim.x) {
    f16v acc[2][2];
    if (t < 512) {
      const int mt = t >> 3, nt = t & 7;
      auto arow = [&](int r) -> const hf* { return A + (size_t)(mt * 128 + r) * 2048; };
      auto brow = [&](int r) -> const hf* { return W + (size_t)(nt * 128 + r) * 2048; };
      gemm_main2<true>(lds, 2048, arow, brow, acc);
      gemm_epi<true>(acc, [&](int m, int n0, float a0, float a1, float a2, float a3) {
        int row = mt * 128 + m, col = nt * 128 + n0;
        float* dst = p.out + ((size_t)b * SEQ + row) * D + col;
        const float* src = (layer == 0) ? p.x + ((size_t)b * SEQ + row) * D + col : dst;
        float4 gt = *(const float4*)(modb + (layer * 3 + b) * 3072 + 2048 + col);
        float4 s = *(const float4*)src;
        *(float4*)dst = make_float4(s.x + gt.x * a0, s.y + gt.y * a1, s.z + gt.z * a2, s.w + gt.w * a3);
      });
    } else {
      const int it = t - 512, tile = it >> 3, ksp = it & 7;
      const int mt = 64 + (tile >> 3), nt = tile & 7;
      auto arow = [&](int r) -> const hf* { return A + (size_t)(mt * 128 + r) * 2048 + ksp * 256; };
      auto brow = [&](int r) -> const hf* { return W + (size_t)(nt * 128 + r) * 2048 + ksp * 256; };
      gemm_main2<true>(lds, 256, arow, brow, acc);
      gemm_epi<true>(acc, [&](int m, int n0, float a0, float a1, float a2, float a3) {
        int row = mt * 128 + m - SEQ, col = nt * 128 + n0;
        float* dst = (float*)(ws + OFF_HCTX) + (size_t)row * D + col;
        float4 gt = *(const float4*)(modb + (0 * 3 + 2) * 3072 + 2048 + col);
        unsafeAtomicAdd(dst + 0, gt.x * a0);
        unsafeAtomicAdd(dst + 1, gt.y * a1);
        unsafeAtomicAdd(dst + 2, gt.z * a2);
        unsafeAtomicAdd(dst + 3, gt.w * a3);
      });
    }
  }
}

DI void phase_inproj1(const Params& p, hf* lds) {
  size_t wsz_ = 0;
  asm volatile("" : "+s"(wsz_));
  char* ws = p.ws + wsz_;
  const hf* A = (const hf*)(ws + OFF_QN);
  const hf* W = (const hf*)(ws + OFF_WDNIN);
  hf* pre = (hf*)(ws + OFF_REC);
  hf* sz = (hf*)(ws + OFF_SZ1);
  float* ab = (float*)(ws + OFF_AB);
  for (int t = blockIdx.x; t < 66 * 49; t += gridDim.x) {
    const int mt = t / 49, nt = t % 49;
    f16v acc[2][2];
    auto arow = [&](int r) -> const hf* { return A + (size_t)(mt * 128 + r) * D; };
    auto brow = [&](int r) -> const hf* { return W + (size_t)(nt * 128 + r) * D; };
    gemm_main2<true>(lds, D, arow, brow, acc);
    gemm_epi<true>(acc, [&](int m, int n0, float a, float b, float c, float d) {
      int row = mt * 128 + m, col = nt * 128 + n0;
      if (nt < 32) *(h4*)(pre + (size_t)row * 4096 + col) = mk4(a, b, c, d);
      else if (nt < 48) *(h4*)(sz + (size_t)row * 2048 + (col - 4096)) = mk4(silu_f(a), silu_f(b), silu_f(c), silu_f(d));
      else if (col - 6144 < 32) *(float4*)(ab + (size_t)row * 32 + (col - 6144)) = make_float4(a, b, c, d);
    });
  }
}

DI void phase_conv(const Params& p, char* ldsc) {
  size_t wsz_ = 0;
  asm volatile("" : "+s"(wsz_));
  char* ws = p.ws + wsz_;
  const int tid = tidx();
  const hf* pre = (const hf*)(ws + OFF_REC);
  hf* tile = (hf*)ldsc;
  const int ch8 = tid & 15, tk = tid >> 4;
  for (int it = blockIdx.x; it < 132 * 32; it += gridDim.x) {
    const int rr = it >> 5, cb = it & 31;
    const bool isctx = rr >= 128;
    const int T = isctx ? CTXL : SEQ;
    const int t0 = isctx ? (rr - 128) * 64 : rr * 64;
    int chbase, kind, head, dvo = 0;
    if (cb < 8) { kind = 0; head = cb; chbase = cb * 128; }
    else if (cb < 16) { kind = 1; head = cb - 8; chbase = 1024 + (cb - 8) * 128; }
    else { kind = 2; head = (cb - 16) >> 1; dvo = ((cb - 16) & 1) * 128; chbase = 2048 + (cb - 16) * 128; }
    const int ch = chbase + ch8 * 8;
    float w[9][8];
#pragma unroll
    for (int k = 0; k < 9; ++k) {
      float4 wa = *(const float4*)(p.dn_conv + k * 4096 + ch), wb = *(const float4*)(p.dn_conv + k * 4096 + ch + 4);
      w[k][0] = wa.x; w[k][1] = wa.y; w[k][2] = wa.z; w[k][3] = wa.w;
      w[k][4] = wb.x; w[k][5] = wb.y; w[k][6] = wb.z; w[k][7] = wb.w;
    }
    auto ldw = [&](int di, int col) -> h8 {
      int row;
      bool ok;
      if (!isctx) {
        int r2 = rr + di - 1;
        ok = (r2 >= 0) && (r2 < 128) && (col >= 0) && (col < 64);
        row = r2 * 64 + col;
      } else {
        int p2 = t0 + col;
        ok = (di == 1) && (p2 >= 0) && (p2 < 256);
        row = SEQ + p2;
      }
      h8 v;
#pragma unroll
      for (int e = 0; e < 8; ++e) v[e] = (hf)0.f;
      if (ok) v = *(const h8*)(pre + (size_t)row * 4096 + ch);
      return v;
    };
    const int c0 = tk * 4;
    h8 win[3][6];
#pragma unroll
    for (int di = 0; di < 3; ++di)
#pragma unroll
      for (int cx = 0; cx < 6; ++cx) win[di][cx] = ldw(di, c0 - 1 + cx);
#pragma unroll
    for (int pp = 0; pp < 4; ++pp) {
      const int cc = c0 + pp;
      float y[8];
#pragma unroll
      for (int e = 0; e < 8; ++e) y[e] = 0.f;
#pragma unroll
      for (int di = 0; di < 3; ++di) {
#pragma unroll
        for (int e = 0; e < 8; ++e)
          y[e] += (float)win[di][pp][e] * w[di * 3 + 0][e] + (float)win[di][pp + 1][e] * w[di * 3 + 1][e] + (float)win[di][pp + 2][e] * w[di * 3 + 2][e];
      }
      float ss = 0.f;
#pragma unroll
      for (int e = 0; e < 8; ++e) { y[e] = silu_f(y[e]); ss += y[e] * y[e]; }
      if (kind < 2) {
        ss += __shfl_xor(ss, 1);
        ss += __shfl_xor(ss, 2);
        ss += __shfl_xor(ss, 4);
        ss += __shfl_xor(ss, 8);
        float sc = rsqrtf(ss + EPS) * (kind == 0 ? 0.08838834764831845f : 1.f);
#pragma unroll
        for (int e = 0; e < 8; ++e) y[e] *= sc;
      }
      h8 o;
#pragma unroll
      for (int e = 0; e < 8; ++e) o[e] = (hf)y[e];
      if (kind < 2) {
        hf* base = (hf*)(ws + (kind == 0 ? OFF_QN : OFF_KN)) + (isctx ? (size_t)8 * SEQ * 128 : 0);
        *(h8*)(base + ((size_t)head * T + t0 + cc) * 128 + ch8 * 8) = o;
      }
      if (kind >= 1) {
#pragma unroll
        for (int e = 0; e < 8; ++e) tile[(ch8 * 8 + e) * 72 + cc] = o[e];
      }
    }
    if (kind >= 1) {
      __syncthreads();
      const int chunk = rr;
      hf* base;
      if (kind == 1) base = (hf*)(ws + OFF_KNT) + ((size_t)(head * 132 + chunk) * 128) * 64;
      else base = (hf*)(ws + OFF_VTT) + ((size_t)(head * 132 + chunk) * 256 + dvo) * 64;
#pragma unroll
      for (int k = 0; k < 4; ++k) {
        int q = tid + 256 * k;
        int c = q >> 3, t8 = q & 7;
        h8 v = *(const h8*)(tile + c * 72 + t8 * 8);
        *(h8*)(base + (size_t)c * 64 + t8 * 8) = v;
      }
      __syncthreads();
    }
  }
}

DI void step_geom(int s, int d, bool& isctx, int& T, int& t0) {
  isctx = s < 4;
  int oc = isctx ? (d ? 3 - s : s) : (d ? 127 - (s - 4) : (s - 4));
  T = isctx ? CTXL : SEQ;
  t0 = oc * 64;
}
DI int step_chunk(int s, int d) {
  return (s < 4) ? 128 + (d ? 3 - s : s) : (d ? 127 - (s - 4) : (s - 4));
}

DI void phase_dprep(const Params& p, char* ldsc) {
  size_t wsz_ = 0;
  asm volatile("" : "+s"(wsz_));
  char* ws = p.ws + wsz_;
  const int tid = tidx(), lane = tid & 63, wid = tid >> 6, hh = lane >> 5, l31 = lane & 31;
  hf* kS = (hf*)ldsc;
  hf* qS = kS + 64 * 136;
  float* Ns = (float*)(qS + 64 * 136);
  hf* Tbs = (hf*)(Ns + 64 * 68);
  hf* Tws = Tbs + 64 * 72;
  float* gcs = (float*)(Tws + 64 * 72);
  float* bts = gcs + 64;
  const float* ab = (const float*)(ws + OFF_AB);
  for (int it = blockIdx.x; it < 8 * 2 * NSTEP; it += gridDim.x) {
    const int h = it / (2 * NSTEP), d = (it / NSTEP) & 1, s = it % NSTEP;
    bool isctx; int T, t0;
    step_geom(s, d, isctx, T, t0);
    const int row0 = isctx ? SEQ + t0 : t0;
    char* rec = ws + OFF_REC + (size_t)it * REC_BYTES;
    const hf* qn = (const hf*)(ws + OFF_QN) + (isctx ? (size_t)8 * SEQ * 128 : 0) + ((size_t)h * T + t0) * 128;
    const hf* kn = (const hf*)(ws + OFF_KN) + (isctx ? (size_t)8 * SEQ * 128 : 0) + ((size_t)h * T + t0) * 128;
    const hf* knt = (const hf*)(ws + OFF_KNT) + ((size_t)(h * 132 + step_chunk(s, d)) * 128) * 64;
    if (tid < 64) {
      const int pp = tid;
      float a = ab[(size_t)(row0 + pp) * 32 + d * 8 + h], bb = ab[(size_t)(row0 + pp) * 32 + 16 + d * 8 + h];
      float xx = a + p.dn_dt_bias[d * 8 + h];
      float sp = fmaxf(xx, 0.f) + log1pf(expf(-fabsf(xx)));
      float g = -expf(p.dn_a_log[d * 8 + h]) * sp;
      float beta = 1.f / (1.f + expf(-bb));
      float v = g;
#pragma unroll
      for (int o = 1; o < 64; o <<= 1) {
        float nb = d ? __shfl_down(v, o) : __shfl_up(v, o);
        bool ok = d ? (pp + o < 64) : (pp >= o);
        if (ok) v += nb;
      }
      gcs[pp] = v;
      bts[pp] = beta;
    }
#pragma unroll
    for (int k = 0; k < 4; ++k) {
      int q = tid + 256 * k;
      int r = q >> 4, c16 = q & 15;
      *(uint4*)(kS + r * 136 + c16 * 8) = ldg4(kn + (size_t)r * 128 + c16 * 8);
      *(uint4*)(qS + r * 136 + c16 * 8) = ldg4(qn + (size_t)r * 128 + c16 * 8);
    }
    __syncthreads();
    const float glast = d ? gcs[0] : gcs[63];
    {
      const int ta = wid >> 1, tb = wid & 1;
      f16v akk, aqk;
#pragma unroll
      for (int r = 0; r < 16; ++r) { akk[r] = 0.f; aqk[r] = 0.f; }
#pragma unroll
      for (int ks = 0; ks < 8; ++ks) {
        h8 fa = *(const h8*)(kS + (ta * 32 + l31) * 136 + ks * 16 + hh * 8);
        h8 fb = *(const h8*)(kS + (tb * 32 + l31) * 136 + ks * 16 + hh * 8);
        h8 fq = *(const h8*)(qS + (tb * 32 + l31) * 136 + ks * 16 + hh * 8);
        akk = mfma16(fa, fb, akk);
        aqk = mfma16(fa, fq, aqk);
      }
      const int pb = tb * 32 + l31;
      const float gb = gcs[pb];
      h8 f0, f1;
#pragma unroll
      for (int r = 0; r < 16; ++r) {
        const int pa = ta * 32 + rowmap(r, hh);
        const float ga = gcs[pa];
        bool strict = d ? (pb > pa) : (pb < pa);
        if (strict) {
          int i = d ? 63 - pa : pa, j = d ? 63 - pb : pb;
          Ns[i * 68 + j] = bts[pa] * akk[r] * __expf(ga - gb);
        }
        bool le = d ? (pa >= pb) : (pa <= pb);
        float v = le ? aqk[r] * __expf(gb - ga) : 0.f;
        if (r < 8) f0[r] = (hf)v; else f1[r - 8] = (hf)v;
      }
      if (!isctx) {
        int slot = (ta == tb) ? ta : ((d ? (ta > tb) : (ta < tb)) ? 2 : -1);
        if (slot >= 0) {
          hf* dst = (hf*)(rec + 16384 + 8192);
          *(h8*)(dst + ((slot * 2 + 0) * 64 + lane) * 8) = f0;
          *(h8*)(dst + ((slot * 2 + 1) * 64 + lane) * 8) = f1;
        }
      }
    }
    __syncthreads();
    float* Tf = (float*)kS;
    float* Xf = Tf + 64 * 68;
    if (wid < 2) {
      const int base = wid * 32, cl = lane & 31;
      int zofs = 0;
      asm volatile("" : "+v"(zofs));
      const float* Nz = Ns + zofs + base * 68 + base;
      float nrow[32];
#pragma unroll
      for (int i = 1; i < 32; ++i) nrow[i] = Nz[i * 68 + cl];
      float tt[32];
#pragma unroll
      for (int i = 0; i < 32; ++i) {
        float a = (i == cl) ? 1.f : 0.f;
        float nr = (i > 0) ? nrow[i] : 0.f;
        if (i > 0) asm volatile("" : "+v"(nr) : "v"(tt[i - 1]));
#pragma unroll
        for (int j = 0; j < i; ++j)
          a -= __builtin_bit_cast(float, __builtin_amdgcn_readlane(__builtin_bit_cast(int, nr), j)) * tt[j];
        tt[i] = a;
      }
      if (lane < 32) {
#pragma unroll
        for (int i = 0; i < 32; ++i) Tf[(base + i) * 68 + base + cl] = tt[i];
      }
    } else if (wid == 2) {
      float* vec = (float*)(rec + 16384 + 8192 + 6144);
      vec[lane] = __expf(gcs[lane]);
      vec[64 + lane] = __expf(glast - gcs[lane]);
      if (lane == 0) vec[128] = __expf(glast);
    }
    __syncthreads();
    {
      const int i = tid >> 3, c4 = (tid & 7) * 4;
      float x0 = 0.f, x1 = 0.f, x2 = 0.f, x3 = 0.f;
#pragma unroll 8
      for (int j = 0; j < 32; ++j) {
        const float n = Ns[(32 + i) * 68 + j];
        const float4 t = *(const float4*)(Tf + j * 68 + c4);
        x0 += n * t.x; x1 += n * t.y; x2 += n * t.z; x3 += n * t.w;
      }
      *(float4*)(Xf + i * 36 + c4) = make_float4(x0, x1, x2, x3);
    }
    __syncthreads();
    {
      const int i = tid >> 3, c4 = (tid & 7) * 4;
      float y0 = 0.f, y1 = 0.f, y2 = 0.f, y3 = 0.f;
#pragma unroll 8
      for (int k = 0; k < 32; ++k) {
        const float t = (k <= i) ? Tf[(32 + i) * 68 + 32 + k] : 0.f;
        const float4 x = *(const float4*)(Xf + k * 36 + c4);
        y0 += t * x.x; y1 += t * x.y; y2 += t * x.z; y3 += t * x.w;
      }
      *(float4*)(Tf + (32 + i) * 68 + c4) = make_float4(-y0, -y1, -y2, -y3);
      *(float4*)(Tf + i * 68 + 32 + c4) = make_float4(0.f, 0.f, 0.f, 0.f);
    }
    __syncthreads();
    {
      const int i = tid >> 2, c0 = (tid & 3) * 16;
      const int pi = d ? 63 - i : i;
#pragma unroll
      for (int e = 0; e < 16; ++e) {
        const int c = c0 + e, pc = d ? 63 - c : c;
        const float v = Tf[i * 68 + c] * bts[pc];
        Tbs[pi * 72 + pc] = (hf)v;
        Tws[pi * 72 + pc] = (hf)(v * __expf(gcs[pc]));
      }
    }
    __syncthreads();
#pragma unroll
    for (int k = 0; k < 2; ++k) {
      int q = tid + 256 * k;
      int r = q >> 3, c8 = q & 7;
      *(uint4*)(rec + 16384 + (size_t)(r * 64 + c8 * 8) * 2) = *(const uint4*)(Tbs + r * 72 + c8 * 8);
    }
    {
      const int dt = wid;
      h8 fa[4];
#pragma unroll
      for (int su = 0; su < 4; ++su) fa[su] = *(const h8*)(knt + (size_t)(dt * 32 + l31) * 64 + su * 16 + hh * 8);
#pragma unroll
      for (int jt = 0; jt < 2; ++jt) {
        f16v a;
#pragma unroll
        for (int r = 0; r < 16; ++r) a[r] = 0.f;
#pragma unroll
        for (int su = 0; su < 4; ++su) {
          h8 fb = *(const h8*)(Tws + (jt * 32 + l31) * 72 + su * 16 + hh * 8);
          a = mfma16(fa[su], fb, a);
        }
        h8 f0, f1;
#pragma unroll
        for (int r = 0; r < 8; ++r) { f0[r] = (hf)(-a[r]); f1[r] = (hf)(-a[8 + r]); }
        hf* dst = (hf*)rec;
        *(h8*)(dst + (((dt * 2 + jt) * 2 + 0) * 64 + lane) * 8) = f0;
        *(h8*)(dst + (((dt * 2 + jt) * 2 + 1) * 64 + lane) * 8) = f1;
      }
    }
    __syncthreads();
  }
}

DI void phase_scan(const Params& p, char* ldsc) {
  size_t wsz_ = 0;
  asm volatile("" : "+s"(wsz_));
  char* ws = p.ws + wsz_;
  const int tid = tidx(), lane = tid & 63, wid = tid >> 6, hh = lane >> 5, l31 = lane & 31;
  const int rw = wid & 1;
  const bool roleB = wid >= 2;
  hf* wS = (hf*)ldsc;
  hf* TbS = wS + 8192;
  hf* qS = TbS + 64 * 64;
  hf* ktS = qS + 64 * 128;
  hf* qkS = ktS + 128 * 64;
  float* vecS = (float*)(qkS + 3072);
  hf* VfS = (hf*)(vecS + 256);
  hf* SfS = VfS + 4 * 64 * 8;
  for (int it = blockIdx.x; it < 128; it += gridDim.x) {
    const int h = it >> 4, d = (it >> 3) & 1, dv8 = it & 7;
    const int dv = dv8 * 32 + l31;
    const char* recb = ws + OFF_REC + (size_t)((h * 2 + d) * NSTEP) * REC_BYTES;
    hf* O = (hf*)(ws + (d ? OFF_O1 : OFF_O0));
    f16v Sd;
#pragma unroll
    for (int r = 0; r < 16; ++r) Sd[r] = 0.f;
    {
      h8 z;
#pragma unroll
      for (int j = 0; j < 8; ++j) z[j] = (hf)0.f;
      *(h8*)(SfS + ((wid * 2 + 0) * 64 + lane) * 8) = z;
      *(h8*)(SfS + ((wid * 2 + 1) * 64 + lane) * 8) = z;
    }
    h8 vt[4];
    const int wid_s = __builtin_amdgcn_readfirstlane(wid);
    auto dma = [&](const void* src, char* dstbase, int L) {
      __builtin_amdgcn_global_load_lds((const unsigned*)src, (unsigned*)(dstbase + (size_t)(L - tid + wid_s * 64) * 16), 16, 0, 0);
    };
    const int offT = (tid >> 3) * 128 + (((tid & 7) ^ ((tid >> 4) & 7)) * 16);
    const int offQ = (tid >> 4) * 256 + (((tid & 15) ^ ((tid >> 4) & 15)) * 16);
    auto issueG1 = [&](int s) {
      bool isctx; int T, t0;
      step_geom(s, d, isctx, T, t0);
      const char* rec = recb + (size_t)s * REC_BYTES;
      const char* qn = (const char*)((const hf*)(ws + OFF_QN) + (isctx ? (size_t)8 * SEQ * 128 : 0) + ((size_t)h * T + t0) * 128);
#pragma unroll
      for (int k = 0; k < 4; ++k) dma(rec + tid * 16 + k * 4096, (char*)wS, tid + 256 * k);
#pragma unroll
      for (int k = 0; k < 2; ++k) dma(rec + 16384 + offT + k * 4096, (char*)TbS, tid + 256 * k);
#pragma unroll
      for (int k = 0; k < 4; ++k) dma(qn + offQ + k * 4096, (char*)qS, tid + 256 * k);
    };
    auto issueG2 = [&](int s) {
      const char* rec = recb + (size_t)s * REC_BYTES;
      const char* knt = (const char*)((const hf*)(ws + OFF_KNT) + ((size_t)(h * 132 + step_chunk(s, d)) * 128) * 64);
#pragma unroll
      for (int k = 0; k < 4; ++k) dma(knt + offT + k * 4096, (char*)ktS, tid + 256 * k);
      dma(rec + 24576 + tid * 16, (char*)qkS, tid);
      if (tid < 192) dma(rec + 24576 + (tid + 256) * 16, (char*)qkS, tid + 256);
    };
    auto loadV = [&](int s) {
      const hf* vtt = (const hf*)(ws + OFF_VTT) + ((size_t)(h * 132 + step_chunk(s, d)) * 256 + dv) * 64;
#pragma unroll
      for (int su = 0; su < 4; ++su) vt[su] = *(const h8*)(vtt + su * 16 + hh * 8);
    };
    issueG1(0);
    if (!roleB) loadV(0);
    __syncthreads();
#pragma unroll 1
    for (int s = 0; s < NSTEP; ++s) {
      bool isctx; int T, t0;
      step_geom(s, d, isctx, T, t0);
      issueG2(s);
      h8 vf[4];
      f16v ao;
#pragma unroll
      for (int r = 0; r < 16; ++r) ao[r] = 0.f;
      if (!roleB) {
        auto ldA = [&](int i) -> h8 {
          if (i < 4) return *(const h8*)(TbS + (rw * 32 + l31) * 64 + (((i * 2 + hh) ^ ((l31 >> 1) & 7)) * 8));
          const int dt = (i - 4) >> 1, sp = (i - 4) & 1;
          return *(const h8*)(wS + (((dt * 2 + rw) * 2 + sp) * 64 + lane) * 8);
        };
        h8 c0 = ldA(0);
#pragma unroll
        for (int i = 0; i < 12; ++i) {
          h8 n0;
          if (i + 1 < 12) n0 = ldA(i + 1);
          __builtin_amdgcn_sched_barrier(0);
          h8 bf;
          if (i < 4) bf = vt[i];
          else bf = *(const h8*)(SfS + ((i - 4) * 64 + lane) * 8);
          ao = mfma16(c0, bf, ao);
          if (i == 3 && s + 1 < NSTEP) loadV(s + 1);
          __builtin_amdgcn_sched_barrier(0);
          if (i + 1 < 12) c0 = n0;
        }
#pragma unroll
        for (int sp = 0; sp < 2; ++sp) *(h8*)(VfS + ((rw * 2 + sp) * 64 + lane) * 8) = cvt8(ao, sp);
      } else if (!isctx) {
        auto ldQ = [&](int i) -> h8 {
          const hf* qrow = qS + (rw * 32 + l31) * 128 + hh * 4;
          h4 lo = *(const h4*)(qrow + (((2 * i) ^ (l31 & 15)) * 8)), hi = *(const h4*)(qrow + (((2 * i + 1) ^ (l31 & 15)) * 8));
          return __builtin_shufflevector(lo, hi, 0, 1, 2, 3, 4, 5, 6, 7);
        };
        h8 q0 = ldQ(0);
#pragma unroll
        for (int i = 0; i < 8; ++i) {
          h8 n0;
          if (i + 1 < 8) n0 = ldQ(i + 1);
          __builtin_amdgcn_sched_barrier(0);
          ao = mfma16(*(const h8*)(SfS + (i * 64 + lane) * 8), q0, ao);
          __builtin_amdgcn_sched_barrier(0);
          if (i + 1 < 8) q0 = n0;
        }
      }
      __syncthreads();
      if (s + 1 < NSTEP) issueG1(s + 1);
      __builtin_amdgcn_sched_barrier(0);
#pragma unroll
      for (int f = 0; f < 4; ++f) vf[f] = *(const h8*)(VfS + (f * 64 + lane) * 8);
      if (roleB && !isctx) {
        const float egi = vecS[rw * 32 + l31];
#pragma unroll
        for (int r = 0; r < 16; ++r) ao[r] *= egi;
#pragma unroll
        for (int jt = 0; jt < 2; ++jt) {
          int slot = (jt == rw) ? jt : ((d ? (jt > rw) : (jt < rw)) ? 2 : -1);
          if (slot >= 0) {
#pragma unroll
            for (int sp = 0; sp < 2; ++sp) {
              h8 fk = *(const h8*)(qkS + ((slot * 2 + sp) * 64 + lane) * 8);
              ao = mfma16(vf[jt * 2 + sp], fk, ao);
            }
          }
        }
        hf* dst = O + (size_t)(t0 + rw * 32 + l31) * 2048 + h * 256 + dv8 * 32 + 4 * hh;
#pragma unroll
        for (int q = 0; q < 4; ++q) *(h4*)(dst + 8 * q) = mk4(ao[4 * q], ao[4 * q + 1], ao[4 * q + 2], ao[4 * q + 3]);
      }
      __builtin_amdgcn_sched_barrier(0);
      {
        const float egl = vecS[128];
        h8 vk[4];
#pragma unroll
        for (int jt = 0; jt < 2; ++jt)
#pragma unroll
          for (int sp = 0; sp < 2; ++sp) {
            h8 f;
#pragma unroll
            for (int j = 0; j < 8; ++j) f[j] = (hf)((float)vf[jt * 2 + sp][j] * vecS[64 + jt * 32 + rowmap(8 * sp + j, hh)]);
            vk[jt * 2 + sp] = f;
          }
#pragma unroll
        for (int r = 0; r < 16; ++r) Sd[r] *= egl;
        {
          const hf* krow = ktS + (wid * 32 + l31) * 64 + hh * 4;
          const int ksw = (l31 >> 1) & 7;
#pragma unroll
          for (int js = 0; js < 4; ++js) {
            h4 lo = *(const h4*)(krow + (((2 * js) ^ ksw) * 8)), hi = *(const h4*)(krow + (((2 * js + 1) ^ ksw) * 8));
            h8 fk = __builtin_shufflevector(lo, hi, 0, 1, 2, 3, 4, 5, 6, 7);
            Sd = mfma16(fk, vk[js], Sd);
          }
          *(h8*)(SfS + ((wid * 2 + 0) * 64 + lane) * 8) = cvt8(Sd, 0);
          *(h8*)(SfS + ((wid * 2 + 1) * 64 + lane) * 8) = cvt8(Sd, 1);
        }
      }
      __syncthreads();
    }
  }
}

DI void phase_onorm(const Params& p) {
  size_t wsz_ = 0;
  asm volatile("" : "+s"(wsz_));
  char* ws = p.ws + wsz_;
  const int tid = tidx(), lane = tid & 63, wid = tid >> 6;
  const hf* O0 = (const hf*)(ws + OFF_O0);
  const hf* O1 = (const hf*)(ws + OFF_O1);
  hf* sz = (hf*)(ws + OFF_SZ1);
  for (int it = blockIdx.x; it < SEQ / 4; it += gridDim.x) {
    const int row = it * 4 + wid;
#pragma unroll
    for (int k = 0; k < 4; ++k) {
      const int e = k * 512 + lane * 8;
      h8 o = *(const h8*)(O0 + (size_t)row * 2048 + e);
      h8 o1 = *(const h8*)(O1 + (size_t)row * 2048 + e);
      float v[8], ss = 0.f;
#pragma unroll
      for (int j = 0; j < 8; ++j) { v[j] = (float)o[j] + (float)o1[j]; ss += v[j] * v[j]; }
#pragma unroll
      for (int m = 1; m <= 16; m <<= 1) ss += __shfl_xor(ss, m);
      const float rstd = rsqrtf(ss * (1.f / 256.f) + EPS);
      const int dvv = e & 255;
      float4 g0 = *(const float4*)(p.dn_norm_g + dvv), g1 = *(const float4*)(p.dn_norm_g + dvv + 4);
      float gg[8] = {g0.x, g0.y, g0.z, g0.w, g1.x, g1.y, g1.z, g1.w};
      h8 z = *(const h8*)(sz + (size_t)row * 2048 + e);
      h8 r;
#pragma unroll
      for (int j = 0; j < 8; ++j) r[j] = (hf)((float)(hf)(v[j] * rstd * gg[j]) * (float)z[j]);
      *(h8*)(sz + (size_t)row * 2048 + e) = r;
    }
  }
}

DI void phase_final(const Params& p, int b) {
  const int tid = tidx(), lane = tid & 63, wid = tid >> 6;
  for (int it = blockIdx.x; it < SEQ / 4; it += gridDim.x) {
    float* row = p.out + ((size_t)b * SEQ + it * 4 + wid) * D;
    float4 v[4];
    float ss = 0.f;
#pragma unroll
    for (int k = 0; k < 4; ++k) {
      v[k] = *(const float4*)(row + k * 256 + lane * 4);
      ss += v[k].x * v[k].x + v[k].y * v[k].y + v[k].z * v[k].z + v[k].w * v[k].w;
    }
#pragma unroll
    for (int o = 32; o >= 1; o >>= 1) ss += __shfl_xor(ss, o);
    const float rstd = rsqrtf(ss * (1.f / 1024.f) + EPS);
#pragma unroll
    for (int k = 0; k < 4; ++k) {
      float4 g = *(const float4*)(p.final_g + k * 256 + lane * 4);
      *(float4*)(row + k * 256 + lane * 4) = make_float4(v[k].x * rstd * g.x, v[k].y * rstd * g.y, v[k].z * rstd * g.z, v[k].w * rstd * g.w);
    }
  }
}


#define XB_TMO      128
#define XB_XCNT(j)  (256  + 64 * (j))
#define XB_XSUB(j)  (1280 + 64 * (j))
#define XB_XGEN(j)  (2304 + 64 * (j))
#define XB_TOP      3328
#define XB_TOPGEN   3392
#define XCD_BAR_WORDS 3456
#define XB_SPIN_CAP (1u << 18)
#define LAS __attribute__((address_space(3)))
DI unsigned xb_ld(unsigned* p) { return __hip_atomic_load(p, __ATOMIC_RELAXED, __HIP_MEMORY_SCOPE_AGENT); }
DI unsigned xb_add(unsigned* p, unsigned v) { return __hip_atomic_fetch_add(p, v, __ATOMIC_RELAXED, __HIP_MEMORY_SCOPE_AGENT); }
DI unsigned xb_xcc_id() { return (unsigned)__builtin_amdgcn_s_getreg((3 << 11) | 20) & 0xFu; }
#define XB_SPIN(cond, bar) do { unsigned _sp = 0; while (cond) { __builtin_amdgcn_s_sleep(1); \
    if ((++_sp & 255u) == 0u) { if (xb_ld(&(bar)[XB_TMO])) break; if (_sp > XB_SPIN_CAP) { atomicAdd(&(bar)[XB_TMO], 1u); break; } } } } while (0)
struct XcdBarrier { unsigned* bar; unsigned x; volatile LAS unsigned* st; };
DI XcdBarrier xcd_barrier_post(unsigned* bar, volatile LAS unsigned* st) {
  XcdBarrier b; b.bar = bar; b.x = xb_xcc_id(); b.st = st;
  if (threadIdx.x == 0) (void)xb_add(&bar[XB_XCNT(b.x)], 1u);
  return b;
}
DI void xcd_barrier_complete(unsigned* bar, unsigned x, unsigned& nloc, unsigned& nx) {
  const unsigned G = gridDim.x * gridDim.y * gridDim.z;
  unsigned sum, cnt, mine, sp = 0u;
  for (;;) {
    sum = 0u; cnt = 0u; mine = 0u;
#pragma unroll
    for (unsigned j = 0; j < 16; ++j) { const unsigned c = xb_ld(&bar[XB_XCNT(j)]); sum += c; cnt += (c > 0u) ? 1u : 0u; mine = (j == x) ? c : mine; }
    if (sum == G) break;
    __builtin_amdgcn_s_sleep(1);
    if ((++sp & 255u) == 0u) { if (xb_ld(&bar[XB_TMO])) break; if (sp > XB_SPIN_CAP) { atomicAdd(&bar[XB_TMO], 1u); break; } }
  }
  nloc = mine > 0u ? mine : 1u; nx = cnt > 0u ? cnt : 1u;
}
DI void xcd_barrier(const XcdBarrier& b) {
  asm volatile("s_waitcnt vmcnt(0)" ::: "memory");
  __syncthreads();
  if (threadIdx.x == 0) {
    unsigned* bar = b.bar;
    __builtin_amdgcn_s_waitcnt(0);
    unsigned nloc = b.st[0], nx = b.st[1];
    if (nloc == 0u) { xcd_barrier_complete(bar, b.x, nloc, nx); b.st[0] = nloc; b.st[1] = nx; }
    const unsigned old = xb_add(&bar[XB_XSUB(b.x)], 1u);
    const unsigned gen = old / nloc;
    if (old + 1u == (gen + 1u) * nloc) {
      __builtin_amdgcn_fence(__ATOMIC_RELEASE, "agent");
      asm volatile("s_waitcnt vmcnt(0)" ::: "memory");
      const unsigned og = xb_add(&bar[XB_TOP], 1u);
      const unsigned tg = og / nx;
      if (og + 1u == (tg + 1u) * nx) xb_add(&bar[XB_TOPGEN], 1u);
      else XB_SPIN(xb_ld(&bar[XB_TOPGEN]) == tg, bar);
      __builtin_amdgcn_fence(__ATOMIC_ACQUIRE, "agent");
      xb_add(&bar[XB_XGEN(b.x)], 1u);
      asm volatile("s_waitcnt vmcnt(0)" ::: "memory");
    } else {
      XB_SPIN(xb_ld(&bar[XB_XGEN(b.x)]) == gen, bar);
      __builtin_amdgcn_fence(__ATOMIC_ACQUIRE, "agent");
      asm volatile("s_waitcnt vmcnt(0)" ::: "memory");
    }
  }
  __syncthreads();
}

#define PROBE_DUP (-1)
constexpr int NPHASE = 1 + 2 * (14 + (PROBE_DUP >= 0 ? 1 : 0));
#define PROBE_REP_MASK 0
#define PROBE_REP_N 2
#define PROBE_XSYNC 0

__global__ void __launch_bounds__(256, 2) fwd_megakernel(Params p) {
  extern __shared__ __attribute__((aligned(16))) char lds[];
  cg::grid_group grid = cg::this_grid();
  volatile LAS unsigned* xbst = (volatile LAS unsigned*)(lds + LDS_BYTES - 16);
  if (threadIdx.x == 0) { xbst[0] = 0u; xbst[1] = 0u; }
  __syncthreads();
  XcdBarrier xb = xcd_barrier_post((unsigned*)(p.ws + OFF_BAR), xbst);
  for (int ph = p.ph_lo; ph < p.ph_hi; ++ph) {
    if (ph > p.ph_lo) {
      if (p.ph_lo < 0) grid.sync();
      xcd_barrier(xb);
      for (int xs = 0; xs < PROBE_XSYNC; ++xs) xcd_barrier(xb);
    }
#ifdef ONLY
    const int b = 0, q = ONLY; if (ONLY < 0) { phase_prep(p, lds, 0); continue; }
#else
    if (ph == 0) { phase_prep(p, lds, 0); continue; }
    constexpr int NPER = 14 + (PROBE_DUP >= 0 ? 1 : 0);
    const int b = (ph - 1) / NPER, e_ = (ph - 1) % NPER;
    const int q = (PROBE_DUP >= 0 && e_ > PROBE_DUP) ? e_ - 1 : e_;
#endif
    for (int rep = 0; rep < ((PROBE_REP_MASK >> q) & 1 ? PROBE_REP_N : 1); ++rep)
    switch (q) {
      case 0: phase_normmod(p, b, 0); phase_prep(p, lds, 1); break;
      case 1: phase_gemm1(p, (hf*)lds); break;
      case 2: phase_stageA(p, (hf*)lds); break;
      case 3: phase_stageB(p, (hf*)lds); break;
      case 4: phase_group(p, (hf*)lds); break;
      case 5: phase_outproj(p, b, 0, (hf*)lds); break;
      case 6: phase_normmod(p, b, 1); break;
      case 7: phase_inproj1(p, (hf*)lds); break;
      case 8: phase_conv(p, lds); break;
      case 9: phase_dprep(p, lds); break;
      case 10: phase_scan(p, lds); break;
      case 11: phase_onorm(p); break;
      case 12: phase_outproj(p, b, 1, (hf*)lds); break;
      case 13: phase_final(p, b); break;
    }
  }
}

extern "C" void kernel_launch(void* const* d_in, const int* in_sizes, int n_in, void* d_out, int out_size, void* d_ws,
                              size_t ws_size, hipStream_t stream) {
  static int grid_blocks = 0;
  if (!grid_blocks) {
    int dev = 0, cus = 0, per_cu = 0;
    hipGetDevice(&dev);
    hipDeviceGetAttribute(&cus, hipDeviceAttributeMultiprocessorCount, dev);
    hipFuncSetAttribute((const void*)fwd_megakernel, hipFuncAttributeMaxDynamicSharedMemorySize, LDS_BYTES);
    hipOccupancyMaxActiveBlocksPerMultiprocessor(&per_cu, (const void*)fwd_megakernel, 256, LDS_BYTES);
    if (per_cu < 1) per_cu = 1;
    if (per_cu > 2) per_cu = 2;
    grid_blocks = cus * per_cu;
    if (ws_size < WS_NEED) fprintf(stderr, "workspace too small: %zu < %zu\n", ws_size, (size_t)WS_NEED);
  }
  Params p{};
  const float** f = (const float**)&p;
  for (int i = 0; i < 17; ++i) f[i] = (const float*)d_in[i];
  p.out = (float*)d_out;
  p.ws = (char*)d_ws;
  p.ph_lo = 0;
  p.ph_hi = NPHASE;
  void* args[] = {&p};
  (void)hipMemsetAsync((char*)d_ws + OFF_BAR, 0, XCD_BAR_WORDS * 4, stream);
  hipError_t e = hipLaunchCooperativeKernel((const void*)fwd_megakernel, dim3(grid_blocks), dim3(256), args, LDS_BYTES, stream);
  if (e != hipSuccess) fprintf(stderr, "cooperative launch failed: %s (grid %d)\n", hipGetErrorString(e), grid_blocks);
}
```

```cpp
#include <hip/hip_runtime.h>
#include <hip/hip_cooperative_groups.h>
#include <cstdio>
namespace cg = cooperative_groups;

typedef _Float16 hf;
typedef hf h8 __attribute__((ext_vector_type(8)));
typedef hf h4 __attribute__((ext_vector_type(4)));
typedef hf h2 __attribute__((ext_vector_type(2)));
typedef float f16v __attribute__((ext_vector_type(16)));

#define DI __device__ __forceinline__

constexpr int D = 1024, SEQ = 8192, CTXL = 256, ROWS = SEQ + CTXL;
constexpr float EPS = 1e-6f;
constexpr size_t MiB = 1ull << 20;
constexpr size_t OFF_WDNIN = 0;
constexpr size_t OFF_WDNOUT = 13 * MiB;
constexpr size_t OFF_TW1 = 17 * MiB;
constexpr size_t OFF_TW2 = OFF_TW1 + 65536;
constexpr size_t OFF_T256 = OFF_TW2 + 32768;
constexpr size_t OFF_TWID = OFF_T256 + 262144;
constexpr size_t OFF_MOD = OFF_TWID + 65536;
constexpr size_t OFF_HCTX = 18 * MiB;
constexpr size_t OFF_AB = 19 * MiB;
constexpr size_t OFF_BAR = 21 * MiB;
constexpr size_t ARENA = 22 * MiB;
constexpr size_t OFF_WFNIN = ARENA + 0;
constexpr size_t OFF_WFNOUT = ARENA + 8 * MiB;
constexpr size_t OFF_WG = 252 * MiB;
constexpr size_t OFF_A0 = ARENA + 14 * MiB;
constexpr size_t OFF_YTL = ARENA + 31 * MiB;
constexpr size_t OFF_YTC = ARENA + 63 * MiB;
constexpr size_t OFF_SZ0 = ARENA + 64 * MiB;
constexpr size_t OFF_ZT = ARENA + 97 * MiB;
constexpr size_t OFF_VT = ARENA + 161 * MiB;
constexpr size_t OFF_QN = ARENA + 0;
constexpr size_t OFF_SZ1 = ARENA + 17 * MiB;
constexpr size_t OFF_REC = ARENA + 50 * MiB;
constexpr size_t OFF_KNT = ARENA + 116 * MiB;
constexpr size_t OFF_VTT = ARENA + 133 * MiB;
constexpr size_t OFF_O0 = ARENA + 166 * MiB;
constexpr size_t OFF_O1 = ARENA + 198 * MiB;
constexpr size_t OFF_KN = ARENA + 198 * MiB;
constexpr size_t WS_NEED = 254 * MiB;
constexpr int REC_BYTES = 31744;
constexpr int NSTEP = 132;
constexpr int LDS_BYTES = 78848;

struct Params {
  const float *x, *c, *ctx, *c_ctx, *mod_w, *mod_b, *norm_g, *final_g, *fn_w_in, *fn_w_grp, *fn_w_out,
      *dn_w_in, *dn_conv, *dn_a_log, *dn_dt_bias, *dn_norm_g, *dn_w_out;
  float* out;
  char* ws;
  int ph_lo, ph_hi;
};

DI int tidx() {
  int t = threadIdx.x;
  asm volatile("" : "+v"(t));
  return t;
}
DI float silu_f(float v) { return v / (1.f + __expf(-v)); }
DI f16v mfma16(h8 a, h8 b, f16v c) { return __builtin_amdgcn_mfma_f32_32x32x16_f16(a, b, c, 0, 0, 0); }
DI uint4 ldg4(const void* p) { return *(const uint4*)p; }
DI int rowmap(int r, int hh) { return 8 * (r >> 2) + 4 * hh + (r & 3); }
DI h8 cvt8(const f16v& a, int s) {
  h8 r;
#pragma unroll
  for (int j = 0; j < 8; ++j) r[j] = (hf)a[8 * s + j];
  return r;
}

constexpr int LDP = 40;
template <bool SWAP, class AF, class BF>
DI void gemm_main(hf* lds, int K, AF arow, BF brow, f16v (&acc)[2][2]) {
  const int tid = tidx(), lane = tid & 63, wid = tid >> 6;
  const int wr = wid >> 1, wc = wid & 1;
  hf* sA = lds;
  hf* sB = lds + 2 * 128 * LDP;
  const int lr = tid >> 2, kc = (tid & 3) * 8;
  const hf* pa0 = arow(lr) + kc;
  const hf* pa1 = arow(lr + 64) + kc;
  const hf* pb0 = brow(lr) + kc;
  const hf* pb1 = brow(lr + 64) + kc;
#pragma unroll
  for (int i = 0; i < 2; ++i)
#pragma unroll
    for (int j = 0; j < 2; ++j)
#pragma unroll
      for (int r = 0; r < 16; ++r) acc[i][j][r] = 0.f;
  uint4 ra0 = ldg4(pa0), ra1 = ldg4(pa1), rb0 = ldg4(pb0), rb1 = ldg4(pb1);
  const int wo0 = lr * LDP + kc, wo1 = (lr + 64) * LDP + kc;
  *(uint4*)(sA + wo0) = ra0;
  *(uint4*)(sA + wo1) = ra1;
  *(uint4*)(sB + wo0) = rb0;
  *(uint4*)(sB + wo1) = rb1;
  __syncthreads();
  const int nk = K >> 5;
  const int aoff = (wr * 64 + (lane & 31)) * LDP + (lane >> 5) * 8;
  const int boff = (wc * 64 + (lane & 31)) * LDP + (lane >> 5) * 8;
  for (int kt = 0; kt < nk; ++kt) {
    const int cur = kt & 1;
    const bool more = (kt + 1 < nk);
    if (more) {
      const int ko = (kt + 1) * 32;
      ra0 = ldg4(pa0 + ko);
      ra1 = ldg4(pa1 + ko);
      rb0 = ldg4(pb0 + ko);
      rb1 = ldg4(pb1 + ko);
    }
    const hf* cA = sA + cur * 128 * LDP;
    const hf* cB = sB + cur * 128 * LDP;
#pragma unroll
    for (int ks = 0; ks < 2; ++ks) {
      h8 a0 = *(const h8*)(cA + aoff + ks * 16), a1 = *(const h8*)(cA + aoff + 32 * LDP + ks * 16);
      h8 b0 = *(const h8*)(cB + boff + ks * 16), b1 = *(const h8*)(cB + boff + 32 * LDP + ks * 16);
      if (SWAP) {
        acc[0][0] = mfma16(b0, a0, acc[0][0]);
        acc[0][1] = mfma16(b1, a0, acc[0][1]);
        acc[1][0] = mfma16(b0, a1, acc[1][0]);
        acc[1][1] = mfma16(b1, a1, acc[1][1]);
      } else {
        acc[0][0] = mfma16(a0, b0, acc[0][0]);
        acc[0][1] = mfma16(a0, b1, acc[0][1]);
        acc[1][0] = mfma16(a1, b0, acc[1][0]);
        acc[1][1] = mfma16(a1, b1, acc[1][1]);
      }
    }
    if (more) {
      hf* nA = sA + (cur ^ 1) * 128 * LDP;
      hf* nB = sB + (cur ^ 1) * 128 * LDP;
      *(uint4*)(nA + wo0) = ra0;
      *(uint4*)(nA + wo1) = ra1;
      *(uint4*)(nB + wo0) = rb0;
      *(uint4*)(nB + wo1) = rb1;
    }
    __syncthreads();
  }
}
template <bool SWAP, class AF, class BF>
DI void gemm_main2(hf* lds, int K, AF arow, BF brow, f16v (&acc)[2][2]) {
  const int tid = tidx(), lane = tid & 63, wid = tid >> 6;
  const int wr = wid >> 1, wc = wid & 1;
  char* ldsb = (char*)lds;
  const int rsub = lane >> 2, cp = lane & 3;
  const int r0 = (wid * 2) * 16 + rsub, r1 = (wid * 2 + 1) * 16 + rsub;
  const int cl0 = (cp ^ ((r0 >> 2) & 3)) * 8, cl1 = (cp ^ ((r1 >> 2) & 3)) * 8;
  const hf* pa0 = arow(r0) + cl0;
  const hf* pa1 = arow(r1) + cl1;
  const hf* pb0 = brow(r0) + cl0;
  const hf* pb1 = brow(r1) + cl1;
  const int dA0 = __builtin_amdgcn_readfirstlane(wid) * 2048, dA1 = dA0 + 1024;
#pragma unroll
  for (int i = 0; i < 2; ++i)
#pragma unroll
    for (int j = 0; j < 2; ++j)
#pragma unroll
      for (int r = 0; r < 16; ++r) acc[i][j][r] = 0.f;
  auto issue = [&](int kt) {
    char* st = ldsb + (kt & 3) * 16384;
    const int ko = kt * 32;
    __builtin_amdgcn_global_load_lds((const unsigned*)(pa0 + ko), (unsigned*)(st + dA0), 16, 0, 0);
    __builtin_amdgcn_global_load_lds((const unsigned*)(pa1 + ko), (unsigned*)(st + dA1), 16, 0, 0);
    __builtin_amdgcn_global_load_lds((const unsigned*)(pb0 + ko), (unsigned*)(st + 8192 + dA0), 16, 0, 0);
    __builtin_amdgcn_global_load_lds((const unsigned*)(pb1 + ko), (unsigned*)(st + 8192 + dA1), 16, 0, 0);
  };
  const int nk = K >> 5;
  issue(0);
  issue(1);
  issue(2);
  const int l31 = lane & 31, hh = lane >> 5, swz = (l31 >> 2) & 3;
  const int fo0 = ((0 + hh) ^ swz) * 16, fo1 = ((2 + hh) ^ swz) * 16;
  const int arb = (wr * 64 + l31) * 64, brb = 8192 + (wc * 64 + l31) * 64;
  for (int kt = 0; kt < nk; ++kt) {
    if (kt + 2 < nk) asm volatile("s_waitcnt vmcnt(8) lgkmcnt(0)" ::: "memory");
    else if (kt + 1 < nk) asm volatile("s_waitcnt vmcnt(4) lgkmcnt(0)" ::: "memory");
    else asm volatile("s_waitcnt vmcnt(0)" ::: "memory");
    __builtin_amdgcn_s_barrier();
    const char* st = ldsb + (kt & 3) * 16384;
#pragma unroll
    for (int ks = 0; ks < 2; ++ks) {
      const int fo = ks ? fo1 : fo0;
      if (ks == 1 && kt + 3 < nk) issue(kt + 3);
      h8 a0 = *(const h8*)(st + arb + fo), a1 = *(const h8*)(st + arb + 2048 + fo);
      h8 b0 = *(const h8*)(st + brb + fo), b1 = *(const h8*)(st + brb + 2048 + fo);
      if (SWAP) {
        acc[0][0] = mfma16(b0, a0, acc[0][0]);
        acc[0][1] = mfma16(b1, a0, acc[0][1]);
        acc[1][0] = mfma16(b0, a1, acc[1][0]);
        acc[1][1] = mfma16(b1, a1, acc[1][1]);
      } else {
        acc[0][0] = mfma16(a0, b0, acc[0][0]);
        acc[0][1] = mfma16(a0, b1, acc[0][1]);
        acc[1][0] = mfma16(a1, b0, acc[1][0]);
        acc[1][1] = mfma16(a1, b1, acc[1][1]);
      }
    }
  }
  __builtin_amdgcn_s_barrier();
}
template <bool SWAP, class F>
DI void gemm_epi(f16v (&acc)[2][2], F f) {
  const int tid = tidx(), lane = tid & 63, wid = tid >> 6;
  const int wr = wid >> 1, wc = wid & 1, hh = lane >> 5, l31 = lane & 31;
#pragma unroll
  for (int i = 0; i < 2; ++i)
#pragma unroll
    for (int j = 0; j < 2; ++j)
#pragma unroll
      for (int q = 0; q < 4; ++q) {
        if (SWAP) {
          int m = wr * 64 + i * 32 + l31, n0 = wc * 64 + j * 32 + 8 * q + 4 * hh;
          f(m, n0, acc[i][j][4 * q], acc[i][j][4 * q + 1], acc[i][j][4 * q + 2], acc[i][j][4 * q + 3]);
        } else {
          int m0 = wr * 64 + i * 32 + 8 * q + 4 * hh, n = wc * 64 + j * 32 + l31;
          f(m0, n, acc[i][j][4 * q], acc[i][j][4 * q + 1], acc[i][j][4 * q + 2], acc[i][j][4 * q + 3]);
        }
      }
}
DI h4 mk4(float a, float b, float c, float d) {
  h4 r;
  r[0] = (hf)a; r[1] = (hf)b; r[2] = (hf)c; r[3] = (hf)d;
  return r;
}

DI void transpose_tile(const float* src, int K, int N, hf* dst, int tk, int tn, float* lds) {
  const int tid = tidx();
  const int c4 = (tid & 15) * 4, n = tn * 64 + c4;
#pragma unroll
  for (int i = 0; i < 4; ++i) {
    int k = (tid >> 4) + i * 16;
    float4 v = make_float4(0.f, 0.f, 0.f, 0.f);
    if (n < N) v = *(const float4*)(src + (size_t)(tk * 64 + k) * N + n);
    lds[k * 65 + c4 + 0] = v.x;
    lds[k * 65 + c4 + 1] = v.y;
    lds[k * 65 + c4 + 2] = v.z;
    lds[k * 65 + c4 + 3] = v.w;
  }
  __syncthreads();
#pragma unroll
  for (int i = 0; i < 2; ++i) {
    int q = tid + i * 256;
    int nn = q >> 3, k8 = (q & 7) * 8;
    h8 o;
#pragma unroll
    for (int j = 0; j < 8; ++j) o[j] = (hf)lds[(k8 + j) * 65 + nn];
    *(h8*)(dst + (size_t)(tn * 64 + nn) * K + tk * 64 + k8) = o;
  }
  __syncthreads();
}

DI void phase_prep(const Params& p, char* ldsc, int which) {
  const int tid = tidx();
  float* lds = (float*)ldsc;
  size_t wsz_ = 0;
  asm volatile("" : "+s"(wsz_));
  char* ws = p.ws + wsz_;
  constexpr int N1 = 1024, N2 = 512, N3 = 1568, N4 = 512, N5 = 512, N6 = 736, N7 = 384;
  constexpr int TOT = N1 + N2 + N3 + N4 + N5 + N6 + N7;
  for (int it = blockIdx.x; it < TOT; it += gridDim.x) {
    int i = it;
    {
      const bool l0 = (i < N1 + N2);
      if (l0 != (which == 1)) continue;
    }
    if (i < N1) { transpose_tile(p.fn_w_in, 1024, 4096, (hf*)(ws + OFF_WFNIN), i / 64, i % 64, lds); continue; }
    i -= N1;
    if (i < N2) { transpose_tile(p.fn_w_out, 2048, 1024, (hf*)(ws + OFF_WFNOUT), i / 16, i % 16, lds); continue; }
    i -= N2;
    if (i < N3) { transpose_tile(p.dn_w_in, 1024, 6176, (hf*)(ws + OFF_WDNIN), i / 98, i % 98, lds); continue; }
    i -= N3;
    if (i < N4) { transpose_tile(p.dn_w_out, 2048, 1024, (hf*)(ws + OFF_WDNOUT), i / 16, i % 16, lds); continue; }
    i -= N4;
    if (i < N5) {
      const int g = i >> 6, c0 = (i & 63) * 4, d = tid;
      float sv, cv;
      sincospif((float)tid / 128.f, &sv, &cv);
      lds[tid] = cv;
      lds[256 + tid] = sv;
      __syncthreads();
      float ac[4], as[4];
#pragma unroll
      for (int j = 0; j < 4; ++j) { ac[j] = 0.f; as[j] = 0.f; }
      const float* w = p.fn_w_grp + (size_t)g * 65536 + d;
#pragma unroll 4
      for (int m = 0; m < 256; ++m) {
        float wv = w[m * 256];
#pragma unroll
        for (int j = 0; j < 4; ++j) {
          int idx = (m * (c0 + j)) & 255;
          ac[j] += lds[idx] * wv;
          as[j] += lds[256 + idx] * wv;
        }
      }
      hf* dst = (hf*)(ws + OFF_WG) + (size_t)(g * 256 + d) * 512;
      *(h4*)(dst + c0) = mk4(ac[0] * 0.0625f, ac[1] * 0.0625f, ac[2] * 0.0625f, ac[3] * 0.0625f);
      *(h4*)(dst + 256 + c0) = mk4(as[0] * 0.0625f, as[1] * 0.0625f, as[2] * 0.0625f, as[3] * 0.0625f);
      __syncthreads();
      continue;
    }
    i -= N5;
    if (i < N6) {
      int e = i * 256 + tid;
      if (e < 32768) {
        int n = e >> 7, l1 = e & 127;
        int im = (n >> 5) & 1, k1 = (n >> 6) * 32 + (n & 31);
        float sv, cv;
        sincospif((float)((k1 * l1) & 127) / 64.f, &sv, &cv);
        ((hf*)(ws + OFF_TW1))[e] = (hf)((im ? -sv : cv) * 0.08838834764831845f);
      } else if (e < 32768 + 16384) {
        int e2 = e - 32768;
        int n = e2 >> 7, kk = e2 & 127;
        int im = n >> 6, k2 = n & 63, l2 = kk & 63, hi = kk >> 6;
        float sv, cv;
        sincospif((float)((k2 * l2) & 63) / 32.f, &sv, &cv);
        float v = (im == 0) ? (hi ? sv : cv) : (hi ? cv : -sv);
        ((hf*)(ws + OFF_TW2))[e2] = (hf)(v * 0.125f);
      } else if (e < 32768 + 16384 + 131072) {
        int e2 = e - 49152;
        int n = e2 >> 8, l = e2 & 255;
        int im = n >> 8, k = n & 255;
        float sv, cv;
        sincospif((float)((k * l) & 255) / 128.f, &sv, &cv);
        ((hf*)(ws + OFF_T256))[e2] = (hf)((im ? -sv : cv) * 0.0625f);
      } else if (e < 32768 + 16384 + 131072 + 8192) {
        int j = e - 180224;
        float sv, cv;
        sincospif((float)j / 4096.f, &sv, &cv);
        ((float*)(ws + OFF_TWID))[2 * j] = cv;
        ((float*)(ws + OFF_TWID))[2 * j + 1] = sv;
      }
      continue;
    }
    i -= N6;
    {
      const int q0 = i * 16, layer = q0 / 3072, n = (q0 % 3072) + (tid & 15), ks = tid >> 4;
      for (int e = tid; e < 3072; e += 256) {
        int cond = e >> 10, k = e & 1023;
        float v = cond == 0 ? p.c[k] : (cond == 1 ? p.c[1024 + k] : p.c_ctx[k]);
        lds[e] = silu_f(v);
      }
      __syncthreads();
      float a0 = 0.f, a1 = 0.f, a2 = 0.f;
      const float* w = p.mod_w + (size_t)layer * 1024 * 3072 + n;
#pragma unroll 16
      for (int k = ks * 64; k < ks * 64 + 64; ++k) {
        float wv = w[(size_t)k * 3072];
        a0 += lds[k] * wv;
        a1 += lds[1024 + k] * wv;
        a2 += lds[2048 + k] * wv;
      }
      float* red = lds + 3072;
      red[(ks * 3 + 0) * 16 + (tid & 15)] = a0;
      red[(ks * 3 + 1) * 16 + (tid & 15)] = a1;
      red[(ks * 3 + 2) * 16 + (tid & 15)] = a2;
      __syncthreads();
      if (tid < 48) {
        int cond = tid >> 4, cl = tid & 15;
        float sacc = 0.f;
#pragma unroll
        for (int j = 0; j < 16; ++j) sacc += red[(j * 3 + cond) * 16 + cl];
        int nn = (q0 % 3072) + cl;
        ((float*)(ws + OFF_MOD))[(layer * 3 + cond) * 3072 + nn] = sacc + p.mod_b[layer * 3072 + nn];
      }
      __syncthreads();
    }
  }
}

DI void phase_normmod(const Params& p, int b, int layer) {
  const int tid = tidx(), lane = tid & 63, wid = tid >> 6;
  size_t wsz_ = 0;
  asm volatile("" : "+s"(wsz_));
  char* ws = p.ws + wsz_;
  hf* A = (hf*)(ws + (layer == 0 ? OFF_A0 : OFF_QN));
  const float* modb = (const float*)(ws + OFF_MOD);
  const float* g = p.norm_g + layer * 1024;
  for (int it = blockIdx.x; it < ROWS / 4; it += gridDim.x) {
    const int r = it * 4 + wid;
    const float* src;
    int cond;
    if (r < SEQ) {
      src = (layer == 0 ? p.x : p.out) + ((size_t)b * SEQ + r) * D;
      cond = b;
    } else {
      src = (layer == 0) ? p.ctx + ((size_t)b * CTXL + (r - SEQ)) * D : (const float*)(ws + OFF_HCTX) + (size_t)(r - SEQ) * D;
      cond = 2;
    }
    const float* mb = modb + (layer * 3 + cond) * 3072;
    float4 v[4];
    float ss = 0.f;
#pragma unroll
    for (int k = 0; k < 4; ++k) {
      v[k] = *(const float4*)(src + k * 256 + lane * 4);
      ss += v[k].x * v[k].x + v[k].y * v[k].y + v[k].z * v[k].z + v[k].w * v[k].w;
    }
#pragma unroll
    for (int o = 32; o >= 1; o >>= 1) ss += __shfl_xor(ss, o);
    const float rstd = rsqrtf(ss * (1.f / 1024.f) + EPS);
#pragma unroll
    for (int k = 0; k < 4; ++k) {
      int col = k * 256 + lane * 4;
      float4 gg = *(const float4*)(g + col), sh = *(const float4*)(mb + col), sc = *(const float4*)(mb + 1024 + col);
      h4 o = mk4(v[k].x * rstd * gg.x * (1.f + sc.x) + sh.x, v[k].y * rstd * gg.y * (1.f + sc.y) + sh.y,
                 v[k].z * rstd * gg.z * (1.f + sc.z) + sh.z, v[k].w * rstd * gg.w * (1.f + sc.w) + sh.w);
      *(h4*)(A + (size_t)r * D + col) = o;
      if (layer == 0 && r >= SEQ) *(float4*)((float*)(ws + OFF_HCTX) + (size_t)(r - SEQ) * D + col) = v[k];
    }
  }
}

DI void phase_gemm1(const Params& p, hf* lds) {
  size_t wsz_ = 0;
  asm volatile("" : "+s"(wsz_));
  char* ws = p.ws + wsz_;
  const hf* A = (const hf*)(ws + OFF_A0);
  const hf* W = (const hf*)(ws + OFF_WFNIN);
  hf* ytl = (hf*)(ws + OFF_YTL);
  hf* ytc = (hf*)(ws + OFF_YTC);
  hf* sz = (hf*)(ws + OFF_SZ0);
  for (int t = blockIdx.x; t < 66 * 32; t += gridDim.x) {
    const int mt = t >> 5, nt = t & 31;
    auto arow = [&](int r) -> const hf* {
      int row = (mt < 64) ? (r * 64 + mt) : (SEQ + (mt - 64) * 128 + r);
      return A + (size_t)row * D;
    };
    auto brow = [&](int r) -> const hf* { return W + (size_t)(nt * 128 + r) * D; };
    f16v acc[2][2];
    if (nt < 16) {
      gemm_main2<false>(lds, D, arow, brow, acc);
      gemm_epi<false>(acc, [&](int m0, int n, float a, float b, float c, float d) {
        int col = nt * 128 + n;
        h4 o = mk4(a, b, c, d);
        if (mt < 64) *(h4*)(ytl + ((size_t)col * 64 + mt) * 128 + m0) = o;
        else *(h4*)(ytc + (size_t)col * 256 + (mt - 64) * 128 + m0) = o;
      });
    } else {
      gemm_main2<true>(lds, D, arow, brow, acc);
      gemm_epi<true>(acc, [&](int m, int n0, float a, float b, float c, float d) {
        int row = (mt < 64) ? (m * 64 + mt) : (SEQ + (mt - 64) * 128 + m);
        int col = (nt - 16) * 128 + n0;
        *(h4*)(sz + (size_t)row * 2048 + col) = mk4(silu_f(a), silu_f(b), silu_f(c), silu_f(d));
      });
    }
  }
}

DI void phase_stageA(const Params& p, hf* lds) {
  size_t wsz_ = 0;
  asm volatile("" : "+s"(wsz_));
  char* ws = p.ws + wsz_;
  const hf* ytl = (const hf*)(ws + OFF_YTL);
  const hf* ytc = (const hf*)(ws + OFF_YTC);
  const hf* w1 = (const hf*)(ws + OFF_TW1);
  const hf* w256 = (const hf*)(ws + OFF_T256);
  const float2* tw = (const float2*)(ws + OFF_TWID);
  hf* zt = (hf*)(ws + OFF_ZT);
  hf* vt = (hf*)(ws + OFF_VT);
  const int lane = tidx() & 63, wid = tidx() >> 6, wr = wid >> 1, wc = wid & 1, hh = lane >> 5, l31 = lane & 31;
  for (int t = blockIdx.x; t < 2048 + 64; t += gridDim.x) {
    f16v acc[2][2];
    if (t < 2048) {
      const int mt = t >> 1, nt = t & 1;
      auto arow = [&](int r) -> const hf* { return ytl + (size_t)(mt * 128 + r) * 128; };
      auto brow = [&](int r) -> const hf* { return w1 + (size_t)(nt * 128 + r) * 128; };
      gemm_main2<false>(lds, 128, arow, brow, acc);
      const int k1 = (nt * 2 + wc) * 32 + l31;
#pragma unroll
      for (int i = 0; i < 2; ++i)
#pragma unroll
        for (int q = 0; q < 4; ++q) {
          const int m0 = mt * 128 + wr * 64 + i * 32 + 8 * q + 4 * hh;
          const int col = m0 >> 6, l2 = m0 & 63;
          float zr[4], zi[4];
#pragma unroll
          for (int e = 0; e < 4; ++e) {
            float2 cs = tw[(k1 * (l2 + e)) & 8191];
            float re = acc[i][0][4 * q + e], im = acc[i][1][4 * q + e];
            zr[e] = re * cs.x + im * cs.y;
            zi[e] = im * cs.x - re * cs.y;
          }
          size_t base = (((size_t)k1 * 2048 + col) * 2) * 64 + l2;
          *(h4*)(zt + base) = mk4(zr[0], zr[1], zr[2], zr[3]);
          *(h4*)(zt + base + 64) = mk4(zi[0], zi[1], zi[2], zi[3]);
        }
    } else {
      const int tt = t - 2048, mt = tt >> 2, nt = tt & 3;
      auto arow = [&](int r) -> const hf* { return ytc + (size_t)(mt * 128 + r) * 256; };
      auto brow = [&](int r) -> const hf* { return w256 + (size_t)(nt * 128 + r) * 256; };
      gemm_main2<false>(lds, 256, arow, brow, acc);
      gemm_epi<false>(acc, [&](int m0, int n, float a, float b, float c, float d) {
        int col = mt * 128 + m0, nn = nt * 128 + n;
        int im = nn >> 8, k = nn & 255, g = col >> 8, cc = col & 255;
        *(h4*)(vt + (size_t)(SEQ + k) * 4096 + g * 512 + im * 256 + cc) = mk4(a, b, c, d);
      });
    }
  }
}

DI void phase_stageB(const Params& p, hf* lds) {
  size_t wsz_ = 0;
  asm volatile("" : "+s"(wsz_));
  char* ws = p.ws + wsz_;
  const hf* zt = (const hf*)(ws + OFF_ZT);
  const hf* w2 = (const hf*)(ws + OFF_TW2);
  hf* vt = (hf*)(ws + OFF_VT);
  for (int t = blockIdx.x; t < 2048; t += gridDim.x) {
    f16v acc[2][2];
    auto arow = [&](int r) -> const hf* { return zt + (size_t)(t * 128 + r) * 128; };
    auto brow = [&](int r) -> const hf* { return w2 + (size_t)r * 128; };
    gemm_main2<false>(lds, 128, arow, brow, acc);
    gemm_epi<false>(acc, [&](int m0, int n, float a, float b, float c, float d) {
      int m = t * 128 + m0;
      int k1 = m >> 11, col = m & 2047, im = n >> 6, k2 = n & 63;
      int g = col >> 8, cc = col & 255;
      *(h4*)(vt + (size_t)(k1 + 128 * k2) * 4096 + g * 512 + im * 256 + cc) = mk4(a, b, c, d);
    });
  }
}

DI void phase_group(const Params& p, hf* lds) {
  size_t wsz_ = 0;
  asm volatile("" : "+s"(wsz_));
  char* ws = p.ws + wsz_;
  const hf* vt = (const hf*)(ws + OFF_VT);
  const hf* wg = (const hf*)(ws + OFF_WG);
  hf* sz = (hf*)(ws + OFF_SZ0);
  for (int t = blockIdx.x; t < 66 * 16; t += gridDim.x) {
    const int mt = t >> 4, g = (t >> 1) & 7, nt = t & 1;
    f16v acc[2][2];
    auto arow = [&](int r) -> const hf* { return vt + (size_t)(mt * 128 + r) * 4096 + g * 512; };
    auto brow = [&](int r) -> const hf* { return wg + (size_t)(g * 256 + nt * 128 + r) * 512; };
    gemm_main2<true>(lds, 512, arow, brow, acc);
    gemm_epi<true>(acc, [&](int m, int n0, float a, float b, float c, float d) {
      hf* q = sz + (size_t)(mt * 128 + m) * 2048 + g * 256 + nt * 128 + n0;
      h4 s = *(const h4*)q;
      *(h4*)q = mk4(a * (float)s[0], b * (float)s[1], c * (float)s[2], d * (float)s[3]);
    });
  }
}

DI void phase_outproj(const Params& p, int b, int layer, hf* lds) {
  size_t wsz_ = 0;
  asm volatile("" : "+s"(wsz_));
  char* ws = p.ws + wsz_;
  const hf* A = (const hf*)(ws + (layer == 0 ? OFF_SZ0 : OFF_SZ1));
  const hf* W = (const hf*)(ws + (layer == 0 ? OFF_WFNOUT : OFF_WDNOUT));
  const float* modb = (const float*)(ws + OFF_MOD);
  const int ntile = layer == 0 ? 512 + 128 : 512;
  for (int t = blockIdx.x; t < ntile; t += gridDim.x) {
    f16v acc[2][2];
    if (t < 512) {
      const int mt = t >> 3, nt = t & 7;
      auto arow = [&](int r) -> const hf* { return A + (size_t)(mt * 128 + r) * 2048; };
      auto brow = [&](int r) -> const hf* { return W + (size_t)(nt * 128 + r) * 2048; };
      gemm_main2<true>(lds, 2048, arow, brow, acc);
      gemm_epi<true>(acc, [&](int m, int n0, float a0, float a1, float a2, float a3) {
        int row = mt * 128 + m, col = nt * 128 + n0;
        float* dst = p.out + ((size_t)b * SEQ + row) * D + col;
        const float* src = (layer == 0) ? p.x + ((size_t)b * SEQ + row) * D + col : dst;
        float4 gt = *(const float4*)(modb + (layer * 3 + b) * 3072 + 2048 + col);
        float4 s = *(const float4*)src;
        *(float4*)dst = make_float4(s.x + gt.x * a0, s.y + gt.y * a1, s.z + gt.z * a2, s.w + gt.w * a3);
      });
    } else {
      const int it = t - 512, tile = it >> 3, ksp = it & 7;
      const int mt = 64 + (tile >> 3), nt = tile & 7;
      auto arow = [&](int r) -> const hf* { return A + (size_t)(mt * 128 + r) * 2048 + ksp * 256; };
      auto brow = [&](int r) -> const hf* { return W + (size_t)(nt * 128 + r) * 2048 + ksp * 256; };
      gemm_main2<true>(lds, 256, arow, brow, acc);
      gemm_epi<true>(acc, [&](int m, int n0, float a0, float a1, float a2, float a3) {
        int row = mt * 128 + m - SEQ, col = nt * 128 + n0;
        float* dst = (float*)(ws + OFF_HCTX) + (size_t)row * D + col;
        float4 gt = *(const float4*)(modb + (0 * 3 + 2) * 3072 + 2048 + col);
        unsafeAtomicAdd(dst + 0, gt.x * a0);
        unsafeAtomicAdd(dst + 1, gt.y * a1);
        unsafeAtomicAdd(dst + 2, gt.z * a2);
        unsafeAtomicAdd(dst + 3, gt.w * a3);
      });
    }
  }
}

DI void phase_inproj1(const Params& p, hf* lds) {
  size_t wsz_ = 0;
  asm volatile("" : "+s"(wsz_));
  char* ws = p.ws + wsz_;
  const hf* A = (const hf*)(ws + OFF_QN);
  const hf* W = (const hf*)(ws + OFF_WDNIN);
  hf* pre = (hf*)(ws + OFF_REC);
  hf* sz = (hf*)(ws + OFF_SZ1);
  float* ab = (float*)(ws + OFF_AB);
  for (int t = blockIdx.x; t < 66 * 49; t += gridDim.x) {
    const int mt = t / 49, nt = t % 49;
    f16v acc[2][2];
    auto arow = [&](int r) -> const hf* { return A + (size_t)(mt * 128 + r) * D; };
    auto brow = [&](int r) -> const hf* { return W + (size_t)(nt * 128 + r) * D; };
    gemm_main2<true>(lds, D, arow, brow, acc);
    gemm_epi<true>(acc, [&](int m, int n0, float a, float b, float c, float d) {
      int row = mt * 128 + m, col = nt * 128 + n0;
      if (nt < 32) *(h4*)(pre + (size_t)row * 4096 + col) = mk4(a, b, c, d);
      else if (nt < 48) *(h4*)(sz + (size_t)row * 2048 + (col - 4096)) = mk4(silu_f(a), silu_f(b), silu_f(c), silu_f(d));
      else if (col - 6144 < 32) *(float4*)(ab + (size_t)row * 32 + (col - 6144)) = make_float4(a, b, c, d);
    });
  }
}

DI void phase_conv(const Params& p, char* ldsc) {
  size_t wsz_ = 0;
  asm volatile("" : "+s"(wsz_));
  char* ws = p.ws + wsz_;
  const int tid = tidx();
  const hf* pre = (const hf*)(ws + OFF_REC);
  hf* tile = (hf*)ldsc;
  const int ch8 = tid & 15, tk = tid >> 4;
  for (int it = blockIdx.x; it < 132 * 32; it += gridDim.x) {
    const int rr = it >> 5, cb = it & 31;
    const bool isctx = rr >= 128;
    const int T = isctx ? CTXL : SEQ;
    const int t0 = isctx ? (rr - 128) * 64 : rr * 64;
    int chbase, kind, head, dvo = 0;
    if (cb < 8) { kind = 0; head = cb; chbase = cb * 128; }
    else if (cb < 16) { kind = 1; head = cb - 8; chbase = 1024 + (cb - 8) * 128; }
    else { kind = 2; head = (cb - 16) >> 1; dvo = ((cb - 16) & 1) * 128; chbase = 2048 + (cb - 16) * 128; }
    const int ch = chbase + ch8 * 8;
    float w[9][8];
#pragma unroll
    for (int k = 0; k < 9; ++k) {
      float4 wa = *(const float4*)(p.dn_conv + k * 4096 + ch), wb = *(const float4*)(p.dn_conv + k * 4096 + ch + 4);
      w[k][0] = wa.x; w[k][1] = wa.y; w[k][2] = wa.z; w[k][3] = wa.w;
      w[k][4] = wb.x; w[k][5] = wb.y; w[k][6] = wb.z; w[k][7] = wb.w;
    }
    auto ldw = [&](int di, int col) -> h8 {
      int row;
      bool ok;
      if (!isctx) {
        int r2 = rr + di - 1;
        ok = (r2 >= 0) && (r2 < 128) && (col >= 0) && (col < 64);
        row = r2 * 64 + col;
      } else {
        int p2 = t0 + col;
        ok = (di == 1) && (p2 >= 0) && (p2 < 256);
        row = SEQ + p2;
      }
      h8 v;
#pragma unroll
      for (int e = 0; e < 8; ++e) v[e] = (hf)0.f;
      if (ok) v = *(const h8*)(pre + (size_t)row * 4096 + ch);
      return v;
    };
    const int c0 = tk * 4;
    h8 win[3][6];
#pragma unroll
    for (int di = 0; di < 3; ++di)
#pragma unroll
      for (int cx = 0; cx < 6; ++cx) win[di][cx] = ldw(di, c0 - 1 + cx);
#pragma unroll
    for (int pp = 0; pp < 4; ++pp) {
      const int cc = c0 + pp;
      float y[8];
#pragma unroll
      for (int e = 0; e < 8; ++e) y[e] = 0.f;
#pragma unroll
      for (int di = 0; di < 3; ++di) {
#pragma unroll
        for (int e = 0; e < 8; ++e)
          y[e] += (float)win[di][pp][e] * w[di * 3 + 0][e] + (float)win[di][pp + 1][e] * w[di * 3 + 1][e] + (float)win[di][pp + 2][e] * w[di * 3 + 2][e];
      }
      float ss = 0.f;
#pragma unroll
      for (int e = 0; e < 8; ++e) { y[e] = silu_f(y[e]); ss += y[e] * y[e]; }
      if (kind < 2) {
        ss += __shfl_xor(ss, 1);
        ss += __shfl_xor(ss, 2);
        ss += __shfl_xor(ss, 4);
        ss += __shfl_xor(ss, 8);
        float sc = rsqrtf(ss + EPS) * (kind == 0 ? 0.08838834764831845f : 1.f);
#pragma unroll
        for (int e = 0; e < 8; ++e) y[e] *= sc;
      }
      h8 o;
#pragma unroll
      for (int e = 0; e < 8; ++e) o[e] = (hf)y[e];
      if (kind < 2) {
        hf* base = (hf*)(ws + (kind == 0 ? OFF_QN : OFF_KN)) + (isctx ? (size_t)8 * SEQ * 128 : 0);
        *(h8*)(base + ((size_t)head * T + t0 + cc) * 128 + ch8 * 8) = o;
      }
      if (kind >= 1) {
#pragma unroll
        for (int e = 0; e < 8; ++e) tile[(ch8 * 8 + e) * 72 + cc] = o[e];
      }
    }
    if (kind >= 1) {
      __syncthreads();
      const int chunk = rr;
      hf* base;
      if (kind == 1) base = (hf*)(ws + OFF_KNT) + ((size_t)(head * 132 + chunk) * 128) * 64;
      else base = (hf*)(ws + OFF_VTT) + ((size_t)(head * 132 + chunk) * 256 + dvo) * 64;
#pragma unroll
      for (int k = 0; k < 4; ++k) {
        int q = tid + 256 * k;
        int c = q >> 3, t8 = q & 7;
        h8 v = *(const h8*)(tile + c * 72 + t8 * 8);
        *(h8*)(base + (size_t)c * 64 + t8 * 8) = v;
      }
      __syncthreads();
    }
  }
}

DI void step_geom(int s, int d, bool& isctx, int& T, int& t0) {
  isctx = s < 4;
  int oc = isctx ? (d ? 3 - s : s) : (d ? 127 - (s - 4) : (s - 4));
  T = isctx ? CTXL : SEQ;
  t0 = oc * 64;
}
DI int step_chunk(int s, int d) {
  return (s < 4) ? 128 + (d ? 3 - s : s) : (d ? 127 - (s - 4) : (s - 4));
}

DI void phase_dprep(const Params& p, char* ldsc) {
  size_t wsz_ = 0;
  asm volatile("" : "+s"(wsz_));
  char* ws = p.ws + wsz_;
  const int tid = tidx(), lane = tid & 63, wid = tid >> 6, hh = lane >> 5, l31 = lane & 31;
  hf* kS = (hf*)ldsc;
  hf* qS = kS + 64 * 136;
  float* Ns = (float*)(qS + 64 * 136);
  hf* Tbs = (hf*)(Ns + 64 * 68);
  hf* Tws = Tbs + 64 * 72;
  float* gcs = (float*)(Tws + 64 * 72);
  float* bts = gcs + 64;
  const float* ab = (const float*)(ws + OFF_AB);
  for (int it = blockIdx.x; it < 8 * 2 * NSTEP; it += gridDim.x) {
    const int h = it / (2 * NSTEP), d = (it / NSTEP) & 1, s = it % NSTEP;
    bool isctx; int T, t0;
    step_geom(s, d, isctx, T, t0);
    const int row0 = isctx ? SEQ + t0 : t0;
    char* rec = ws + OFF_REC + (size_t)it * REC_BYTES;
    const hf* qn = (const hf*)(ws + OFF_QN) + (isctx ? (size_t)8 * SEQ * 128 : 0) + ((size_t)h * T + t0) * 128;
    const hf* kn = (const hf*)(ws + OFF_KN) + (isctx ? (size_t)8 * SEQ * 128 : 0) + ((size_t)h * T + t0) * 128;
    const hf* knt = (const hf*)(ws + OFF_KNT) + ((size_t)(h * 132 + step_chunk(s, d)) * 128) * 64;
    if (tid < 64) {
      const int pp = tid;
      float a = ab[(size_t)(row0 + pp) * 32 + d * 8 + h], bb = ab[(size_t)(row0 + pp) * 32 + 16 + d * 8 + h];
      float xx = a + p.dn_dt_bias[d * 8 + h];
      float sp = fmaxf(xx, 0.f) + log1pf(expf(-fabsf(xx)));
      float g = -expf(p.dn_a_log[d * 8 + h]) * sp;
      float beta = 1.f / (1.f + expf(-bb));
      float v = g;
#pragma unroll
      for (int o = 1; o < 64; o <<= 1) {
        float nb = d ? __shfl_down(v, o) : __shfl_up(v, o);
        bool ok = d ? (pp + o < 64) : (pp >= o);
        if (ok) v += nb;
      }
      gcs[pp] = v;
      bts[pp] = beta;
    }
#pragma unroll
    for (int k = 0; k < 4; ++k) {
      int q = tid + 256 * k;
      int r = q >> 4, c16 = q & 15;
      *(uint4*)(kS + r * 136 + c16 * 8) = ldg4(kn + (size_t)r * 128 + c16 * 8);
      *(uint4*)(qS + r * 136 + c16 * 8) = ldg4(qn + (size_t)r * 128 + c16 * 8);
    }
    __syncthreads();
    const float glast = d ? gcs[0] : gcs[63];
    {
      const int ta = wid >> 1, tb = wid & 1;
      f16v akk, aqk;
#pragma unroll
      for (int r = 0; r < 16; ++r) { akk[r] = 0.f; aqk[r] = 0.f; }
#pragma unroll
      for (int ks = 0; ks < 8; ++ks) {
        h8 fa = *(const h8*)(kS + (ta * 32 + l31) * 136 + ks * 16 + hh * 8);
        h8 fb = *(const h8*)(kS + (tb * 32 + l31) * 136 + ks * 16 + hh * 8);
        h8 fq = *(const h8*)(qS + (tb * 32 + l31) * 136 + ks * 16 + hh * 8);
        akk = mfma16(fa, fb, akk);
        aqk = mfma16(fa, fq, aqk);
      }
      const int pb = tb * 32 + l31;
      const float gb = gcs[pb];
      h8 f0, f1;
#pragma unroll
      for (int r = 0; r < 16; ++r) {
        const int pa = ta * 32 + rowmap(r, hh);
        const float ga = gcs[pa];
        bool strict = d ? (pb > pa) : (pb < pa);
        if (strict) {
          int i = d ? 63 - pa : pa, j = d ? 63 - pb : pb;
          Ns[i * 68 + j] = bts[pa] * akk[r] * __expf(ga - gb);
        }
        bool le = d ? (pa >= pb) : (pa <= pb);
        float v = le ? aqk[r] * __expf(gb - ga) : 0.f;
        if (r < 8) f0[r] = (hf)v; else f1[r - 8] = (hf)v;
      }
      if (!isctx) {
        int slot = (ta == tb) ? ta : ((d ? (ta > tb) : (ta < tb)) ? 2 : -1);
        if (slot >= 0) {
          hf* dst = (hf*)(rec + 16384 + 8192);
          *(h8*)(dst + ((slot * 2 + 0) * 64 + lane) * 8) = f0;
          *(h8*)(dst + ((slot * 2 + 1) * 64 + lane) * 8) = f1;
        }
      }
    }
    __syncthreads();
    float* Tf = (float*)kS;
    float* Xf = Tf + 64 * 68;
    if (wid < 2) {
      const int base = wid * 32, cl = lane & 31;
      int zofs = 0;
      asm volatile("" : "+v"(zofs));
      const float* Nz = Ns + zofs + base * 68 + base;
      float nrow[32];
#pragma unroll
      for (int i = 1; i < 32; ++i) nrow[i] = Nz[i * 68 + cl];
      float tt[32];
#pragma unroll
      for (int i = 0; i < 32; ++i) {
        float a = (i == cl) ? 1.f : 0.f;
        float nr = (i > 0) ? nrow[i] : 0.f;
        if (i > 0) asm volatile("" : "+v"(nr) : "v"(tt[i - 1]));
#pragma unroll
        for (int j = 0; j < i; ++j)
          a -= __builtin_bit_cast(float, __builtin_amdgcn_readlane(__builtin_bit_cast(int, nr), j)) * tt[j];
        tt[i] = a;
      }
      if (lane < 32) {
#pragma unroll
        for (int i = 0; i < 32; ++i) Tf[(base + i) * 68 + base + cl] = tt[i];
      }
    } else if (wid == 2) {
      float* vec = (float*)(rec + 16384 + 8192 + 6144);
      vec[lane] = __expf(gcs[lane]);
      vec[64 + lane] = __expf(glast - gcs[lane]);
      if (lane == 0) vec[128] = __expf(glast);
    }
    __syncthreads();
    {
      const int i = tid >> 3, c4 = (tid & 7) * 4;
      float x0 = 0.f, x1 = 0.f, x2 = 0.f, x3 = 0.f;
#pragma unroll 8
      for (int j = 0; j < 32; ++j) {
        const float n = Ns[(32 + i) * 68 + j];
        const float4 t = *(const float4*)(Tf + j * 68 + c4);
        x0 += n * t.x; x1 += n * t.y; x2 += n * t.z; x3 += n * t.w;
      }
      *(float4*)(Xf + i * 36 + c4) = make_float4(x0, x1, x2, x3);
    }
    __syncthreads();
    {
      const int i = tid >> 3, c4 = (tid & 7) * 4;
      float y0 = 0.f, y1 = 0.f, y2 = 0.f, y3 = 0.f;
#pragma unroll 8
      for (int k = 0; k < 32; ++k) {
        const float t = (k <= i) ? Tf[(32 + i) * 68 + 32 + k] : 0.f;
        const float4 x = *(const float4*)(Xf + k * 36 + c4);
        y0 += t * x.x; y1 += t * x.y; y2 += t * x.z; y3 += t * x.w;
      }
      *(float4*)(Tf + (32 + i) * 68 + c4) = make_float4(-y0, -y1, -y2, -y3);
      *(float4*)(Tf + i * 68 + 32 + c4) = make_float4(0.f, 0.f, 0.f, 0.f);
    }
    __syncthreads();
    {
      const int i = tid >> 2, c0 = (tid & 3) * 16;
      const int pi = d ? 63 - i : i;
#pragma unroll
      for (int e = 0; e < 16; ++e) {
        const int c = c0 + e, pc = d ? 63 - c : c;
        const float v = Tf[i * 68 + c] * bts[pc];
        Tbs[pi * 72 + pc] = (hf)v;
        Tws[pi * 72 + pc] = (hf)(v * __expf(gcs[pc]));
      }
    }
    __syncthreads();
#pragma unroll
    for (int k = 0; k < 2; ++k) {
      int q = tid + 256 * k;
      int r = q >> 3, c8 = q & 7;
      *(uint4*)(rec + 16384 + (size_t)(r * 64 + c8 * 8) * 2) = *(const uint4*)(Tbs + r * 72 + c8 * 8);
    }
    {
      const int dt = wid;
      h8 fa[4];
#pragma unroll
      for (int su = 0; su < 4; ++su) fa[su] = *(const h8*)(knt + (size_t)(dt * 32 + l31) * 64 + su * 16 + hh * 8);
#pragma unroll
      for (int jt = 0; jt < 2; ++jt) {
        f16v a;
#pragma unroll
        for (int r = 0; r < 16; ++r) a[r] = 0.f;
#pragma unroll
        for (int su = 0; su < 4; ++su) {
          h8 fb = *(const h8*)(Tws + (jt * 32 + l31) * 72 + su * 16 + hh * 8);
          a = mfma16(fa[su], fb, a);
        }
        h8 f0, f1;
#pragma unroll
        for (int r = 0; r < 8; ++r) { f0[r] = (hf)(-a[r]); f1[r] = (hf)(-a[8 + r]); }
        hf* dst = (hf*)rec;
        *(h8*)(dst + (((dt * 2 + jt) * 2 + 0) * 64 + lane) * 8) = f0;
        *(h8*)(dst + (((dt * 2 + jt) * 2 + 1) * 64 + lane) * 8) = f1;
      }
    }
    __syncthreads();
  }
}

DI void phase_scan(const Params& p, char* ldsc) {
  size_t wsz_ = 0;
  asm volatile("" : "+s"(wsz_));
  char* ws = p.ws + wsz_;
  const int tid = tidx(), lane = tid & 63, wid = tid >> 6, hh = lane >> 5, l31 = lane & 31;
  const int rw = wid & 1;
  const bool roleB = wid >= 2;
  hf* wS = (hf*)ldsc;
  hf* TbS = wS + 8192;
  hf* qS = TbS + 64 * 64;
  hf* ktS = qS + 64 * 128;
  hf* qkS = ktS + 128 * 64;
  float* vecS = (float*)(qkS + 3072);
  hf* VfS = (hf*)(vecS + 256);
  hf* SfS = VfS + 4 * 64 * 8;
  for (int it = blockIdx.x; it < 128; it += gridDim.x) {
    const int h = it >> 4, d = (it >> 3) & 1, dv8 = it & 7;
    const int dv = dv8 * 32 + l31;
    const char* recb = ws + OFF_REC + (size_t)((h * 2 + d) * NSTEP) * REC_BYTES;
    hf* O = (hf*)(ws + (d ? OFF_O1 : OFF_O0));
    f16v Sd;
#pragma unroll
    for (int r = 0; r < 16; ++r) Sd[r] = 0.f;
    {
      h8 z;
#pragma unroll
      for (int j = 0; j < 8; ++j) z[j] = (hf)0.f;
      *(h8*)(SfS + ((wid * 2 + 0) * 64 + lane) * 8) = z;
      *(h8*)(SfS + ((wid * 2 + 1) * 64 + lane) * 8) = z;
    }
    h8 vt[4];
    const int wid_s = __builtin_amdgcn_readfirstlane(wid);
    auto dma = [&](const void* src, char* dstbase, int L) {
      __builtin_amdgcn_global_load_lds((const unsigned*)src, (unsigned*)(dstbase + (size_t)(L - tid + wid_s * 64) * 16), 16, 0, 0);
    };
    const int offT = (tid >> 3) * 128 + (((tid & 7) ^ ((tid >> 4) & 7)) * 16);
    const int offQ = (tid >> 4) * 256 + (((tid & 15) ^ ((tid >> 4) & 15)) * 16);
    auto issueG1 = [&](int s) {
      bool isctx; int T, t0;
      step_geom(s, d, isctx, T, t0);
      const char* rec = recb + (size_t)s * REC_BYTES;
      const char* qn = (const char*)((const hf*)(ws + OFF_QN) + (isctx ? (size_t)8 * SEQ * 128 : 0) + ((size_t)h * T + t0) * 128);
#pragma unroll
      for (int k = 0; k < 4; ++k) dma(rec + tid * 16 + k * 4096, (char*)wS, tid + 256 * k);
#pragma unroll
      for (int k = 0; k < 2; ++k) dma(rec + 16384 + offT + k * 4096, (char*)TbS, tid + 256 * k);
#pragma unroll
      for (int k = 0; k < 4; ++k) dma(qn + offQ + k * 4096, (char*)qS, tid + 256 * k);
    };
    auto issueG2 = [&](int s) {
      const char* rec = recb + (size_t)s * REC_BYTES;
      const char* knt = (const char*)((const hf*)(ws + OFF_KNT) + ((size_t)(h * 132 + step_chunk(s, d)) * 128) * 64);
#pragma unroll
      for (int k = 0; k < 4; ++k) dma(knt + offT + k * 4096, (char*)ktS, tid + 256 * k);
      dma(rec + 24576 + tid * 16, (char*)qkS, tid);
      if (tid < 192) dma(rec + 24576 + (tid + 256) * 16, (char*)qkS, tid + 256);
    };
    auto loadV = [&](int s) {
      const hf* vtt = (const hf*)(ws + OFF_VTT) + ((size_t)(h * 132 + step_chunk(s, d)) * 256 + dv) * 64;
#pragma unroll
      for (int su = 0; su < 4; ++su) vt[su] = *(const h8*)(vtt + su * 16 + hh * 8);
    };
    issueG1(0);
    if (!roleB) loadV(0);
    __syncthreads();
#pragma unroll 1
    for (int s = 0; s < NSTEP; ++s) {
      bool isctx; int T, t0;
      step_geom(s, d, isctx, T, t0);
      issueG2(s);
      h8 vf[4];
      f16v ao;
#pragma unroll
      for (int r = 0; r < 16; ++r) ao[r] = 0.f;
      if (!roleB) {
        auto ldA = [&](int i) -> h8 {
          if (i < 4) return *(const h8*)(TbS + (rw * 32 + l31) * 64 + (((i * 2 + hh) ^ ((l31 >> 1) & 7)) * 8));
          const int dt = (i - 4) >> 1, sp = (i - 4) & 1;
          return *(const h8*)(wS + (((dt * 2 + rw) * 2 + sp) * 64 + lane) * 8);
        };
        h8 c0 = ldA(0);
#pragma unroll
        for (int i = 0; i < 12; ++i) {
          h8 n0;
          if (i + 1 < 12) n0 = ldA(i + 1);
          __builtin_amdgcn_sched_barrier(0);
          h8 bf;
          if (i < 4) bf = vt[i];
          else bf = *(const h8*)(SfS + ((i - 4) * 64 + lane) * 8);
          ao = mfma16(c0, bf, ao);
          if (i == 3 && s + 1 < NSTEP) loadV(s + 1);
          __builtin_amdgcn_sched_barrier(0);
          if (i + 1 < 12) c0 = n0;
        }
#pragma unroll
        for (int sp = 0; sp < 2; ++sp) *(h8*)(VfS + ((rw * 2 + sp) * 64 + lane) * 8) = cvt8(ao, sp);
      } else if (!isctx) {
        auto ldQ = [&](int i) -> h8 {
          const hf* qrow = qS + (rw * 32 + l31) * 128 + hh * 4;
          h4 lo = *(const h4*)(qrow + (((2 * i) ^ (l31 & 15)) * 8)), hi = *(const h4*)(qrow + (((2 * i + 1) ^ (l31 & 15)) * 8));
          return __builtin_shufflevector(lo, hi, 0, 1, 2, 3, 4, 5, 6, 7);
        };
        h8 q0 = ldQ(0);
#pragma unroll
        for (int i = 0; i < 8; ++i) {
          h8 n0;
          if (i + 1 < 8) n0 = ldQ(i + 1);
          __builtin_amdgcn_sched_barrier(0);
          ao = mfma16(*(const h8*)(SfS + (i * 64 + lane) * 8), q0, ao);
          __builtin_amdgcn_sched_barrier(0);
          if (i + 1 < 8) q0 = n0;
        }
      }
      if (!roleB && s + 1 < NSTEP) asm volatile("s_waitcnt vmcnt(4) lgkmcnt(0)" ::: "memory");
      else asm volatile("s_waitcnt vmcnt(0) lgkmcnt(0)" ::: "memory");
      __builtin_amdgcn_s_barrier();
      if (s + 1 < NSTEP) issueG1(s + 1);
      __builtin_amdgcn_sched_barrier(0);
#pragma unroll
      for (int f = 0; f < 4; ++f) vf[f] = *(const h8*)(VfS + (f * 64 + lane) * 8);
      if (roleB && !isctx) {
        const float egi = vecS[rw * 32 + l31];
#pragma unroll
        for (int r = 0; r < 16; ++r) ao[r] *= egi;
#pragma unroll
        for (int jt = 0; jt < 2; ++jt) {
          int slot = (jt == rw) ? jt : ((d ? (jt > rw) : (jt < rw)) ? 2 : -1);
          if (slot >= 0) {
#pragma unroll
            for (int sp = 0; sp < 2; ++sp) {
              h8 fk = *(const h8*)(qkS + ((slot * 2 + sp) * 64 + lane) * 8);
              ao = mfma16(vf[jt * 2 + sp], fk, ao);
            }
          }
        }
        hf* dst = O + (size_t)(t0 + rw * 32 + l31) * 2048 + h * 256 + dv8 * 32 + 4 * hh;
#pragma unroll
        for (int q = 0; q < 4; ++q) *(h4*)(dst + 8 * q) = mk4(ao[4 * q], ao[4 * q + 1], ao[4 * q + 2], ao[4 * q + 3]);
      }
      __builtin_amdgcn_sched_barrier(0);
      {
        const float egl = vecS[128];
        h8 vk[4];
#pragma unroll
        for (int jt = 0; jt < 2; ++jt)
#pragma unroll
          for (int sp = 0; sp < 2; ++sp) {
            h8 f;
#pragma unroll
            for (int j = 0; j < 8; ++j) f[j] = (hf)((float)vf[jt * 2 + sp][j] * vecS[64 + jt * 32 + rowmap(8 * sp + j, hh)]);
            vk[jt * 2 + sp] = f;
          }
#pragma unroll
        for (int r = 0; r < 16; ++r) Sd[r] *= egl;
        {
          const hf* krow = ktS + (wid * 32 + l31) * 64 + hh * 4;
          const int ksw = (l31 >> 1) & 7;
#pragma unroll
          for (int js = 0; js < 4; ++js) {
            h4 lo = *(const h4*)(krow + (((2 * js) ^ ksw) * 8)), hi = *(const h4*)(krow + (((2 * js + 1) ^ ksw) * 8));
            h8 fk = __builtin_shufflevector(lo, hi, 0, 1, 2, 3, 4, 5, 6, 7);
            Sd = mfma16(fk, vk[js], Sd);
          }
          *(h8*)(SfS + ((wid * 2 + 0) * 64 + lane) * 8) = cvt8(Sd, 0);
          *(h8*)(SfS + ((wid * 2 + 1) * 64 + lane) * 8) = cvt8(Sd, 1);
        }
      }
      __syncthreads();
    }
  }
}

DI void phase_onorm(const Params& p) {
  size_t wsz_ = 0;
  asm volatile("" : "+s"(wsz_));
  char* ws = p.ws + wsz_;
  const int tid = tidx(), lane = tid & 63, wid = tid >> 6;
  const hf* O0 = (const hf*)(ws + OFF_O0);
  const hf* O1 = (const hf*)(ws + OFF_O1);
  hf* sz = (hf*)(ws + OFF_SZ1);
  for (int it = blockIdx.x; it < SEQ / 4; it += gridDim.x) {
    const int row = it * 4 + wid;
#pragma unroll
    for (int k = 0; k < 4; ++k) {
      const int e = k * 512 + lane * 8;
      h8 o = *(const h8*)(O0 + (size_t)row * 2048 + e);
      h8 o1 = *(const h8*)(O1 + (size_t)row * 2048 + e);
      float v[8], ss = 0.f;
#pragma unroll
      for (int j = 0; j < 8; ++j) { v[j] = (float)o[j] + (float)o1[j]; ss += v[j] * v[j]; }
#pragma unroll
      for (int m = 1; m <= 16; m <<= 1) ss += __shfl_xor(ss, m);
      const float rstd = rsqrtf(ss * (1.f / 256.f) + EPS);
      const int dvv = e & 255;
      float4 g0 = *(const float4*)(p.dn_norm_g + dvv), g1 = *(const float4*)(p.dn_norm_g + dvv + 4);
      float gg[8] = {g0.x, g0.y, g0.z, g0.w, g1.x, g1.y, g1.z, g1.w};
      h8 z = *(const h8*)(sz + (size_t)row * 2048 + e);
      h8 r;
#pragma unroll
      for (int j = 0; j < 8; ++j) r[j] = (hf)((float)(hf)(v[j] * rstd * gg[j]) * (float)z[j]);
      *(h8*)(sz + (size_t)row * 2048 + e) = r;
    }
  }
}

DI void phase_final(const Params& p, int b) {
  const int tid = tidx(), lane = tid & 63, wid = tid >> 6;
  for (int it = blockIdx.x; it < SEQ / 4; it += gridDim.x) {
    float* row = p.out + ((size_t)b * SEQ + it * 4 + wid) * D;
    float4 v[4];
    float ss = 0.f;
#pragma unroll
    for (int k = 0; k < 4; ++k) {
      v[k] = *(const float4*)(row + k * 256 + lane * 4);
      ss += v[k].x * v[k].x + v[k].y * v[k].y + v[k].z * v[k].z + v[k].w * v[k].w;
    }
#pragma unroll
    for (int o = 32; o >= 1; o >>= 1) ss += __shfl_xor(ss, o);
    const float rstd = rsqrtf(ss * (1.f / 1024.f) + EPS);
#pragma unroll
    for (int k = 0; k < 4; ++k) {
      float4 g = *(const float4*)(p.final_g + k * 256 + lane * 4);
      *(float4*)(row + k * 256 + lane * 4) = make_float4(v[k].x * rstd * g.x, v[k].y * rstd * g.y, v[k].z * rstd * g.z, v[k].w * rstd * g.w);
    }
  }
}


#define XB_TMO      128
#define XB_XCNT(j)  (256  + 64 * (j))
#define XB_XSUB(j)  (1280 + 64 * (j))
#define XB_XGEN(j)  (2304 + 64 * (j))
#define XB_TOP      3328
#define XB_TOPGEN   3392
#define XCD_BAR_WORDS 3456
#define XB_SPIN_CAP (1u << 18)
#define LAS __attribute__((address_space(3)))
DI unsigned xb_ld(unsigned* p) { return __hip_atomic_load(p, __ATOMIC_RELAXED, __HIP_MEMORY_SCOPE_AGENT); }
DI unsigned xb_add(unsigned* p, unsigned v) { return __hip_atomic_fetch_add(p, v, __ATOMIC_RELAXED, __HIP_MEMORY_SCOPE_AGENT); }
DI unsigned xb_xcc_id() { return (unsigned)__builtin_amdgcn_s_getreg((3 << 11) | 20) & 0xFu; }
#define XB_SPIN(cond, bar) do { unsigned _sp = 0; while (cond) { __builtin_amdgcn_s_sleep(1); \
    if ((++_sp & 255u) == 0u) { if (xb_ld(&(bar)[XB_TMO])) break; if (_sp > XB_SPIN_CAP) { atomicAdd(&(bar)[XB_TMO], 1u); break; } } } } while (0)
struct XcdBarrier { unsigned* bar; unsigned x; volatile LAS unsigned* st; };
DI XcdBarrier xcd_barrier_post(unsigned* bar, volatile LAS unsigned* st) {
  XcdBarrier b; b.bar = bar; b.x = xb_xcc_id(); b.st = st;
  if (threadIdx.x == 0) (void)xb_add(&bar[XB_XCNT(b.x)], 1u);
  return b;
}
DI void xcd_barrier_complete(unsigned* bar, unsigned x, unsigned& nloc, unsigned& nx) {
  const unsigned G = gridDim.x * gridDim.y * gridDim.z;
  unsigned sum, cnt, mine, sp = 0u;
  for (;;) {
    sum = 0u; cnt = 0u; mine = 0u;
#pragma unroll
    for (unsigned j = 0; j < 16; ++j) { const unsigned c = xb_ld(&bar[XB_XCNT(j)]); sum += c; cnt += (c > 0u) ? 1u : 0u; mine = (j == x) ? c : mine; }
    if (sum == G) break;
    __builtin_amdgcn_s_sleep(1);
    if ((++sp & 255u) == 0u) { if (xb_ld(&bar[XB_TMO])) break; if (sp > XB_SPIN_CAP) { atomicAdd(&bar[XB_TMO], 1u); break; } }
  }
  nloc = mine > 0u ? mine : 1u; nx = cnt > 0u ? cnt : 1u;
}
DI void xcd_barrier(const XcdBarrier& b) {
  asm volatile("s_waitcnt vmcnt(0)" ::: "memory");
  __syncthreads();
  if (threadIdx.x == 0) {
    unsigned* bar = b.bar;
    __builtin_amdgcn_s_waitcnt(0);
    unsigned nloc = b.st[0], nx = b.st[1];
    if (nloc == 0u) { xcd_barrier_complete(bar, b.x, nloc, nx); b.st[0] = nloc; b.st[1] = nx; }
    const unsigned old = xb_add(&bar[XB_XSUB(b.x)], 1u);
    const unsigned gen = old / nloc;
    if (old + 1u == (gen + 1u) * nloc) {
      __builtin_amdgcn_fence(__ATOMIC_RELEASE, "agent");
      asm volatile("s_waitcnt vmcnt(0)" ::: "memory");
      const unsigned og = xb_add(&bar[XB_TOP], 1u);
      const unsigned tg = og / nx;
      if (og + 1u == (tg + 1u) * nx) xb_add(&bar[XB_TOPGEN], 1u);
      else XB_SPIN(xb_ld(&bar[XB_TOPGEN]) == tg, bar);
      __builtin_amdgcn_fence(__ATOMIC_ACQUIRE, "agent");
      xb_add(&bar[XB_XGEN(b.x)], 1u);
      asm volatile("s_waitcnt vmcnt(0)" ::: "memory");
    } else {
      XB_SPIN(xb_ld(&bar[XB_XGEN(b.x)]) == gen, bar);
      __builtin_amdgcn_fence(__ATOMIC_ACQUIRE, "agent");
      asm volatile("s_waitcnt vmcnt(0)" ::: "memory");
    }
  }
  __syncthreads();
}

#define PROBE_DUP (-1)
constexpr int NPHASE = 1 + 2 * (14 + (PROBE_DUP >= 0 ? 1 : 0));
#define PROBE_REP_MASK 0
#define PROBE_REP_N 2
#define PROBE_XSYNC 0

__global__ void __launch_bounds__(256, 2) fwd_megakernel(Params p) {
  extern __shared__ __attribute__((aligned(16))) char lds[];
  cg::grid_group grid = cg::this_grid();
  volatile LAS unsigned* xbst = (volatile LAS unsigned*)(lds + LDS_BYTES - 16);
  if (threadIdx.x == 0) { xbst[0] = 0u; xbst[1] = 0u; }
  __syncthreads();
  XcdBarrier xb = xcd_barrier_post((unsigned*)(p.ws + OFF_BAR), xbst);
  for (int ph = p.ph_lo; ph < p.ph_hi; ++ph) {
    if (ph > p.ph_lo) {
      if (p.ph_lo < 0) grid.sync();
      xcd_barrier(xb);
      for (int xs = 0; xs < PROBE_XSYNC; ++xs) xcd_barrier(xb);
    }
#ifdef ONLY
    const int b = 0, q = ONLY; if (ONLY < 0) { phase_prep(p, lds, 0); continue; }
#else
    if (ph == 0) { phase_prep(p, lds, 0); continue; }
    constexpr int NPER = 14 + (PROBE_DUP >= 0 ? 1 : 0);
    const int b = (ph - 1) / NPER, e_ = (ph - 1) % NPER;
    const int q = (PROBE_DUP >= 0 && e_ > PROBE_DUP) ? e_ - 1 : e_;
#endif
    for (int rep = 0; rep < ((PROBE_REP_MASK >> q) & 1 ? PROBE_REP_N : 1); ++rep)
    switch (q) {
      case 0: phase_normmod(p, b, 0); phase_prep(p, lds, 1); break;
      case 1: phase_gemm1(p, (hf*)lds); break;
      case 2: phase_stageA(p, (hf*)lds); break;
      case 3: phase_stageB(p, (hf*)lds); break;
      case 4: phase_group(p, (hf*)lds); break;
      case 5: phase_outproj(p, b, 0, (hf*)lds); break;
      case 6: phase_normmod(p, b, 1); break;
      case 7: phase_inproj1(p, (hf*)lds); break;
      case 8: phase_conv(p, lds); break;
      case 9: phase_dprep(p, lds); break;
      case 10: phase_scan(p, lds); break;
      case 11: phase_onorm(p); break;
      case 12: phase_outproj(p, b, 1, (hf*)lds); break;
      case 13: phase_final(p, b); break;
    }
  }
}

extern "C" void kernel_launch(void* const* d_in, const int* in_sizes, int n_in, void* d_out, int out_size, void* d_ws,
                              size_t ws_size, hipStream_t stream) {
  static int grid_blocks = 0;
  if (!grid_blocks) {
    int dev = 0, cus = 0, per_cu = 0;
    hipGetDevice(&dev);
    hipDeviceGetAttribute(&cus, hipDeviceAttributeMultiprocessorCount, dev);
    hipFuncSetAttribute((const void*)fwd_megakernel, hipFuncAttributeMaxDynamicSharedMemorySize, LDS_BYTES);
    hipOccupancyMaxActiveBlocksPerMultiprocessor(&per_cu, (const void*)fwd_megakernel, 256, LDS_BYTES);
    if (per_cu < 1) per_cu = 1;
    if (per_cu > 2) per_cu = 2;
    grid_blocks = cus * per_cu;
    if (ws_size < WS_NEED) fprintf(stderr, "workspace too small: %zu < %zu\n", ws_size, (size_t)WS_NEED);
  }
  Params p{};
  const float** f = (const float**)&p;
  for (int i = 0; i < 17; ++i) f[i] = (const float*)d_in[i];
  p.out = (float*)d_out;
  p.ws = (char*)d_ws;
  p.ph_lo = 0;
  p.ph_hi = NPHASE;
  void* args[] = {&p};
  (void)hipMemsetAsync((char*)d_ws + OFF_BAR, 0, XCD_BAR_WORDS * 4, stream);
  hipError_t e = hipLaunchCooperativeKernel((const void*)fwd_megakernel, dim3(grid_blocks), dim3(256), args, LDS_BYTES, stream);
  if (e != hipSuccess) fprintf(stderr, "cooperative launch failed: %s (grid %d)\n", hipGetErrorString(e), grid_blocks);
}
```

```cpp
#include <hip/hip_runtime.h>
#include <hip/hip_cooperative_groups.h>
#include <cstdio>
namespace cg = cooperative_groups;

typedef _Float16 hf;
typedef hf h8 __attribute__((ext_vector_type(8)));
typedef hf h4 __attribute__((ext_vector_type(4)));
typedef hf h2 __attribute__((ext_vector_type(2)));
typedef float f16v __attribute__((ext_vector_type(16)));

#define DI __device__ __forceinline__

constexpr int D = 1024, SEQ = 8192, CTXL = 256, ROWS = SEQ + CTXL;
constexpr float EPS = 1e-6f;
constexpr size_t MiB = 1ull << 20;
constexpr size_t OFF_WDNIN = 0;
constexpr size_t OFF_WDNOUT = 13 * MiB;
constexpr size_t OFF_TW1 = 17 * MiB;
constexpr size_t OFF_TW2 = OFF_TW1 + 65536;
constexpr size_t OFF_T256 = OFF_TW2 + 32768;
constexpr size_t OFF_TWID = OFF_T256 + 262144;
constexpr size_t OFF_MOD = OFF_TWID + 65536;
constexpr size_t OFF_HCTX = 18 * MiB;
constexpr size_t OFF_AB = 19 * MiB;
constexpr size_t OFF_BAR = 21 * MiB;
constexpr size_t ARENA = 22 * MiB;
constexpr size_t OFF_WFNIN = ARENA + 0;
constexpr size_t OFF_WFNOUT = ARENA + 8 * MiB;
constexpr size_t OFF_WG = 252 * MiB;
constexpr size_t OFF_A0 = ARENA + 14 * MiB;
constexpr size_t OFF_YTL = ARENA + 31 * MiB;
constexpr size_t OFF_YTC = ARENA + 63 * MiB;
constexpr size_t OFF_SZ0 = ARENA + 64 * MiB;
constexpr size_t OFF_ZT = ARENA + 97 * MiB;
constexpr size_t OFF_VT = ARENA + 161 * MiB;
constexpr size_t OFF_QN = ARENA + 0;
constexpr size_t OFF_SZ1 = ARENA + 17 * MiB;
constexpr size_t OFF_REC = ARENA + 50 * MiB;
constexpr size_t OFF_KNT = ARENA + 116 * MiB;
constexpr size_t OFF_VTT = ARENA + 133 * MiB;
constexpr size_t OFF_O0 = ARENA + 166 * MiB;
constexpr size_t OFF_O1 = ARENA + 198 * MiB;
constexpr size_t OFF_KN = ARENA + 198 * MiB;
constexpr size_t WS_NEED = 254 * MiB;
constexpr int REC_BYTES = 31744;
constexpr int NSTEP = 132;
constexpr int LDS_BYTES = 78848;

struct Params {
  const float *x, *c, *ctx, *c_ctx, *mod_w, *mod_b, *norm_g, *final_g, *fn_w_in, *fn_w_grp, *fn_w_out,
      *dn_w_in, *dn_conv, *dn_a_log, *dn_dt_bias, *dn_norm_g, *dn_w_out;
  float* out;
  char* ws;
  int ph_lo, ph_hi;
};

DI int tidx() {
  int t = threadIdx.x;
  asm volatile("" : "+v"(t));
  return t;
}
DI float silu_f(float v) { return v / (1.f + __expf(-v)); }
DI f16v mfma16(h8 a, h8 b, f16v c) { return __builtin_amdgcn_mfma_f32_32x32x16_f16(a, b, c, 0, 0, 0); }
DI uint4 ldg4(const void* p) { return *(const uint4*)p; }
DI int rowmap(int r, int hh) { return 8 * (r >> 2) + 4 * hh + (r & 3); }
DI h8 cvt8(const f16v& a, int s) {
  h8 r;
#pragma unroll
  for (int j = 0; j < 8; ++j) r[j] = (hf)a[8 * s + j];
  return r;
}

constexpr int LDP = 40;
template <bool SWAP, class AF, class BF>
DI void gemm_main(hf* lds, int K, AF arow, BF brow, f16v (&acc)[2][2]) {
  const int tid = tidx(), lane = tid & 63, wid = tid >> 6;
  const int wr = wid >> 1, wc = wid & 1;
  hf* sA = lds;
  hf* sB = lds + 2 * 128 * LDP;
  const int lr = tid >> 2, kc = (tid & 3) * 8;
  const hf* pa0 = arow(lr) + kc;
  const hf* pa1 = arow(lr + 64) + kc;
  const hf* pb0 = brow(lr) + kc;
  const hf* pb1 = brow(lr + 64) + kc;
#pragma unroll
  for (int i = 0; i < 2; ++i)
#pragma unroll
    for (int j = 0; j < 2; ++j)
#pragma unroll
      for (int r = 0; r < 16; ++r) acc[i][j][r] = 0.f;
  uint4 ra0 = ldg4(pa0), ra1 = ldg4(pa1), rb0 = ldg4(pb0), rb1 = ldg4(pb1);
  const int wo0 = lr * LDP + kc, wo1 = (lr + 64) * LDP + kc;
  *(uint4*)(sA + wo0) = ra0;
  *(uint4*)(sA + wo1) = ra1;
  *(uint4*)(sB + wo0) = rb0;
  *(uint4*)(sB + wo1) = rb1;
  __syncthreads();
  const int nk = K >> 5;
  const int aoff = (wr * 64 + (lane & 31)) * LDP + (lane >> 5) * 8;
  const int boff = (wc * 64 + (lane & 31)) * LDP + (lane >> 5) * 8;
  for (int kt = 0; kt < nk; ++kt) {
    const int cur = kt & 1;
    const bool more = (kt + 1 < nk);
    if (more) {
      const int ko = (kt + 1) * 32;
      ra0 = ldg4(pa0 + ko);
      ra1 = ldg4(pa1 + ko);
      rb0 = ldg4(pb0 + ko);
      rb1 = ldg4(pb1 + ko);
    }
    const hf* cA = sA + cur * 128 * LDP;
    const hf* cB = sB + cur * 128 * LDP;
#pragma unroll
    for (int ks = 0; ks < 2; ++ks) {
      h8 a0 = *(const h8*)(cA + aoff + ks * 16), a1 = *(const h8*)(cA + aoff + 32 * LDP + ks * 16);
      h8 b0 = *(const h8*)(cB + boff + ks * 16), b1 = *(const h8*)(cB + boff + 32 * LDP + ks * 16);
      if (SWAP) {
        acc[0][0] = mfma16(b0, a0, acc[0][0]);
        acc[0][1] = mfma16(b1, a0, acc[0][1]);
        acc[1][0] = mfma16(b0, a1, acc[1][0]);
        acc[1][1] = mfma16(b1, a1, acc[1][1]);
      } else {
        acc[0][0] = mfma16(a0, b0, acc[0][0]);
        acc[0][1] = mfma16(a0, b1, acc[0][1]);
        acc[1][0] = mfma16(a1, b0, acc[1][0]);
        acc[1][1] = mfma16(a1, b1, acc[1][1]);
      }
    }
    if (more) {
      hf* nA = sA + (cur ^ 1) * 128 * LDP;
      hf* nB = sB + (cur ^ 1) * 128 * LDP;
      *(uint4*)(nA + wo0) = ra0;
      *(uint4*)(nA + wo1) = ra1;
      *(uint4*)(nB + wo0) = rb0;
      *(uint4*)(nB + wo1) = rb1;
    }
    __syncthreads();
  }
}
template <bool SWAP, class AF, class BF>
DI void gemm_main2(hf* lds, int K, AF arow, BF brow, f16v (&acc)[2][2]) {
  const int tid = tidx(), lane = tid & 63, wid = tid >> 6;
  const int wr = wid >> 1, wc = wid & 1;
  char* ldsb = (char*)lds;
  const int rsub = lane >> 2, cp = lane & 3;
  const int r0 = (wid * 2) * 16 + rsub, r1 = (wid * 2 + 1) * 16 + rsub;
  const int cl0 = (cp ^ ((r0 >> 2) & 3)) * 8, cl1 = (cp ^ ((r1 >> 2) & 3)) * 8;
  const hf* pa0 = arow(r0) + cl0;
  const hf* pa1 = arow(r1) + cl1;
  const hf* pb0 = brow(r0) + cl0;
  const hf* pb1 = brow(r1) + cl1;
  const int dA0 = __builtin_amdgcn_readfirstlane(wid) * 2048, dA1 = dA0 + 1024;
#pragma unroll
  for (int i = 0; i < 2; ++i)
#pragma unroll
    for (int j = 0; j < 2; ++j)
#pragma unroll
      for (int r = 0; r < 16; ++r) acc[i][j][r] = 0.f;
  auto issue = [&](int kt) {
    char* st = ldsb + (kt & 3) * 16384;
    const int ko = kt * 32;
    __builtin_amdgcn_global_load_lds((const unsigned*)(pa0 + ko), (unsigned*)(st + dA0), 16, 0, 0);
    __builtin_amdgcn_global_load_lds((const unsigned*)(pa1 + ko), (unsigned*)(st + dA1), 16, 0, 0);
    __builtin_amdgcn_global_load_lds((const unsigned*)(pb0 + ko), (unsigned*)(st + 8192 + dA0), 16, 0, 0);
    __builtin_amdgcn_global_load_lds((const unsigned*)(pb1 + ko), (unsigned*)(st + 8192 + dA1), 16, 0, 0);
  };
  const int nk = K >> 5;
  issue(0);
  issue(1);
  issue(2);
  const int l31 = lane & 31, hh = lane >> 5, swz = (l31 >> 2) & 3;
  const int fo0 = ((0 + hh) ^ swz) * 16, fo1 = ((2 + hh) ^ swz) * 16;
  const int arb = (wr * 64 + l31) * 64, brb = 8192 + (wc * 64 + l31) * 64;
  for (int kt = 0; kt < nk; ++kt) {
    if (kt + 2 < nk) asm volatile("s_waitcnt vmcnt(8) lgkmcnt(0)" ::: "memory");
    else if (kt + 1 < nk) asm volatile("s_waitcnt vmcnt(4) lgkmcnt(0)" ::: "memory");
    else asm volatile("s_waitcnt vmcnt(0)" ::: "memory");
    __builtin_amdgcn_s_barrier();
    const char* st = ldsb + (kt & 3) * 16384;
#pragma unroll
    for (int ks = 0; ks < 2; ++ks) {
      const int fo = ks ? fo1 : fo0;
      if (ks == 1 && kt + 3 < nk) issue(kt + 3);
      h8 a0 = *(const h8*)(st + arb + fo), a1 = *(const h8*)(st + arb + 2048 + fo);
      h8 b0 = *(const h8*)(st + brb + fo), b1 = *(const h8*)(st + brb + 2048 + fo);
      if (SWAP) {
        acc[0][0] = mfma16(b0, a0, acc[0][0]);
        acc[0][1] = mfma16(b1, a0, acc[0][1]);
        acc[1][0] = mfma16(b0, a1, acc[1][0]);
        acc[1][1] = mfma16(b1, a1, acc[1][1]);
      } else {
        acc[0][0] = mfma16(a0, b0, acc[0][0]);
        acc[0][1] = mfma16(a0, b1, acc[0][1]);
        acc[1][0] = mfma16(a1, b0, acc[1][0]);
        acc[1][1] = mfma16(a1, b1, acc[1][1]);
      }
    }
  }
  __builtin_amdgcn_s_barrier();
}
template <bool SWAP, class F>
DI void gemm_epi(f16v (&acc)[2][2], F f) {
  const int tid = tidx(), lane = tid & 63, wid = tid >> 6;
  const int wr = wid >> 1, wc = wid & 1, hh = lane >> 5, l31 = lane & 31;
#pragma unroll
  for (int i = 0; i < 2; ++i)
#pragma unroll
    for (int j = 0; j < 2; ++j)
#pragma unroll
      for (int q = 0; q < 4; ++q) {
        if (SWAP) {
          int m = wr * 64 + i * 32 + l31, n0 = wc * 64 + j * 32 + 8 * q + 4 * hh;
          f(m, n0, acc[i][j][4 * q], acc[i][j][4 * q + 1], acc[i][j][4 * q + 2], acc[i][j][4 * q + 3]);
        } else {
          int m0 = wr * 64 + i * 32 + 8 * q + 4 * hh, n = wc * 64 + j * 32 + l31;
          f(m0, n, acc[i][j][4 * q], acc[i][j][4 * q + 1], acc[i][j][4 * q + 2], acc[i][j][4 * q + 3]);
        }
      }
}
DI h4 mk4(float a, float b, float c, float d) {
  h4 r;
  r[0] = (hf)a; r[1] = (hf)b; r[2] = (hf)c; r[3] = (hf)d;
  return r;
}

DI void transpose_tile(const float* src, int K, int N, hf* dst, int tk, int tn, float* lds) {
  const int tid = tidx();
  const int c4 = (tid & 15) * 4, n = tn * 64 + c4;
#pragma unroll
  for (int i = 0; i < 4; ++i) {
    int k = (tid >> 4) + i * 16;
    float4 v = make_float4(0.f, 0.f, 0.f, 0.f);
    if (n < N) v = *(const float4*)(src + (size_t)(tk * 64 + k) * N + n);
    lds[k * 65 + c4 + 0] = v.x;
    lds[k * 65 + c4 + 1] = v.y;
    lds[k * 65 + c4 + 2] = v.z;
    lds[k * 65 + c4 + 3] = v.w;
  }
  __syncthreads();
#pragma unroll
  for (int i = 0; i < 2; ++i) {
    int q = tid + i * 256;
    int nn = q >> 3, k8 = (q & 7) * 8;
    h8 o;
#pragma unroll
    for (int j = 0; j < 8; ++j) o[j] = (hf)lds[(k8 + j) * 65 + nn];
    *(h8*)(dst + (size_t)(tn * 64 + nn) * K + tk * 64 + k8) = o;
  }
  __syncthreads();
}

DI void phase_prep(const Params& p, char* ldsc, int which) {
  const int tid = tidx();
  float* lds = (float*)ldsc;
  size_t wsz_ = 0;
  asm volatile("" : "+s"(wsz_));
  char* ws = p.ws + wsz_;
  constexpr int N1 = 1024, N2 = 512, N3 = 1568, N4 = 512, N5 = 512, N6 = 736, N7 = 384;
  constexpr int TOT = N1 + N2 + N3 + N4 + N5 + N6 + N7;
  for (int it = blockIdx.x; it < TOT; it += gridDim.x) {
    int i = it;
    {
      const bool l0 = (i < N1 + N2);
      if (l0 != (which == 1)) continue;
    }
    if (i < N1) { transpose_tile(p.fn_w_in, 1024, 4096, (hf*)(ws + OFF_WFNIN), i / 64, i % 64, lds); continue; }
    i -= N1;
    if (i < N2) { transpose_tile(p.fn_w_out, 2048, 1024, (hf*)(ws + OFF_WFNOUT), i / 16, i % 16, lds); continue; }
    i -= N2;
    if (i < N3) { transpose_tile(p.dn_w_in, 1024, 6176, (hf*)(ws + OFF_WDNIN), i / 98, i % 98, lds); continue; }
    i -= N3;
    if (i < N4) { transpose_tile(p.dn_w_out, 2048, 1024, (hf*)(ws + OFF_WDNOUT), i / 16, i % 16, lds); continue; }
    i -= N4;
    if (i < N5) {
      const int g = i >> 6, c0 = (i & 63) * 4, d = tid;
      float sv, cv;
      sincospif((float)tid / 128.f, &sv, &cv);
      lds[tid] = cv;
      lds[256 + tid] = sv;
      __syncthreads();
      float ac[4], as[4];
#pragma unroll
      for (int j = 0; j < 4; ++j) { ac[j] = 0.f; as[j] = 0.f; }
      const float* w = p.fn_w_grp + (size_t)g * 65536 + d;
#pragma unroll 4
      for (int m = 0; m < 256; ++m) {
        float wv = w[m * 256];
#pragma unroll
        for (int j = 0; j < 4; ++j) {
          int idx = (m * (c0 + j)) & 255;
          ac[j] += lds[idx] * wv;
          as[j] += lds[256 + idx] * wv;
        }
      }
      hf* dst = (hf*)(ws + OFF_WG) + (size_t)(g * 256 + d) * 512;
      *(h4*)(dst + c0) = mk4(ac[0] * 0.0625f, ac[1] * 0.0625f, ac[2] * 0.0625f, ac[3] * 0.0625f);
      *(h4*)(dst + 256 + c0) = mk4(as[0] * 0.0625f, as[1] * 0.0625f, as[2] * 0.0625f, as[3] * 0.0625f);
      __syncthreads();
      continue;
    }
    i -= N5;
    if (i < N6) {
      int e = i * 256 + tid;
      if (e < 32768) {
        int n = e >> 7, l1 = e & 127;
        int im = (n >> 5) & 1, k1 = (n >> 6) * 32 + (n & 31);
        float sv, cv;
        sincospif((float)((k1 * l1) & 127) / 64.f, &sv, &cv);
        ((hf*)(ws + OFF_TW1))[e] = (hf)((im ? -sv : cv) * 0.08838834764831845f);
      } else if (e < 32768 + 16384) {
        int e2 = e - 32768;
        int n = e2 >> 7, kk = e2 & 127;
        int im = n >> 6, k2 = n & 63, l2 = kk & 63, hi = kk >> 6;
        float sv, cv;
        sincospif((float)((k2 * l2) & 63) / 32.f, &sv, &cv);
        float v = (im == 0) ? (hi ? sv : cv) : (hi ? cv : -sv);
        ((hf*)(ws + OFF_TW2))[e2] = (hf)(v * 0.125f);
      } else if (e < 32768 + 16384 + 131072) {
        int e2 = e - 49152;
        int n = e2 >> 8, l = e2 & 255;
        int im = n >> 8, k = n & 255;
        float sv, cv;
        sincospif((float)((k * l) & 255) / 128.f, &sv, &cv);
        ((hf*)(ws + OFF_T256))[e2] = (hf)((im ? -sv : cv) * 0.0625f);
      } else if (e < 32768 + 16384 + 131072 + 8192) {
        int j = e - 180224;
        float sv, cv;
        sincospif((float)j / 4096.f, &sv, &cv);
        ((float*)(ws + OFF_TWID))[2 * j] = cv;
        ((float*)(ws + OFF_TWID))[2 * j + 1] = sv;
      }
      continue;
    }
    i -= N6;
    {
      const int q0 = i * 16, layer = q0 / 3072, n = (q0 % 3072) + (tid & 15), ks = tid >> 4;
      for (int e = tid; e < 3072; e += 256) {
        int cond = e >> 10, k = e & 1023;
        float v = cond == 0 ? p.c[k] : (cond == 1 ? p.c[1024 + k] : p.c_ctx[k]);
        lds[e] = silu_f(v);
      }
      __syncthreads();
      float a0 = 0.f, a1 = 0.f, a2 = 0.f;
      const float* w = p.mod_w + (size_t)layer * 1024 * 3072 + n;
#pragma unroll 16
      for (int k = ks * 64; k < ks * 64 + 64; ++k) {
        float wv = w[(size_t)k * 3072];
        a0 += lds[k] * wv;
        a1 += lds[1024 + k] * wv;
        a2 += lds[2048 + k] * wv;
      }
      float* red = lds + 3072;
      red[(ks * 3 + 0) * 16 + (tid & 15)] = a0;
      red[(ks * 3 + 1) * 16 + (tid & 15)] = a1;
      red[(ks * 3 + 2) * 16 + (tid & 15)] = a2;
      __syncthreads();
      if (tid < 48) {
        int cond = tid >> 4, cl = tid & 15;
        float sacc = 0.f;
#pragma unroll
        for (int j = 0; j < 16; ++j) sacc += red[(j * 3 + cond) * 16 + cl];
        int nn = (q0 % 3072) + cl;
        ((float*)(ws + OFF_MOD))[(layer * 3 + cond) * 3072 + nn] = sacc + p.mod_b[layer * 3072 + nn];
      }
      __syncthreads();
    }
  }
}

DI void phase_normmod(const Params& p, int b, int layer) {
  const int tid = tidx(), lane = tid & 63, wid = tid >> 6;
  size_t wsz_ = 0;
  asm volatile("" : "+s"(wsz_));
  char* ws = p.ws + wsz_;
  hf* A = (hf*)(ws + (layer == 0 ? OFF_A0 : OFF_QN));
  const float* modb = (const float*)(ws + OFF_MOD);
  const float* g = p.norm_g + layer * 1024;
  for (int it = blockIdx.x; it < ROWS / 4; it += gridDim.x) {
    const int r = it * 4 + wid;
    const float* src;
    int cond;
    if (r < SEQ) {
      src = (layer == 0 ? p.x : p.out) + ((size_t)b * SEQ + r) * D;
      cond = b;
    } else {
      src = (layer == 0) ? p.ctx + ((size_t)b * CTXL + (r - SEQ)) * D : (const float*)(ws + OFF_HCTX) + (size_t)(r - SEQ) * D;
      cond = 2;
    }
    const float* mb = modb + (layer * 3 + cond) * 3072;
    float4 v[4];
    float ss = 0.f;
#pragma unroll
    for (int k = 0; k < 4; ++k) {
      v[k] = *(const float4*)(src + k * 256 + lane * 4);
      ss += v[k].x * v[k].x + v[k].y * v[k].y + v[k].z * v[k].z + v[k].w * v[k].w;
    }
#pragma unroll
    for (int o = 32; o >= 1; o >>= 1) ss += __shfl_xor(ss, o);
    const float rstd = rsqrtf(ss * (1.f / 1024.f) + EPS);
#pragma unroll
    for (int k = 0; k < 4; ++k) {
      int col = k * 256 + lane * 4;
      float4 gg = *(const float4*)(g + col), sh = *(const float4*)(mb + col), sc = *(const float4*)(mb + 1024 + col);
      h4 o = mk4(v[k].x * rstd * gg.x * (1.f + sc.x) + sh.x, v[k].y * rstd * gg.y * (1.f + sc.y) + sh.y,
                 v[k].z * rstd * gg.z * (1.f + sc.z) + sh.z, v[k].w * rstd * gg.w * (1.f + sc.w) + sh.w);
      *(h4*)(A + (size_t)r * D + col) = o;
      if (layer == 0 && r >= SEQ) *(float4*)((float*)(ws + OFF_HCTX) + (size_t)(r - SEQ) * D + col) = v[k];
    }
  }
}

DI void phase_gemm1(const Params& p, hf* lds) {
  size_t wsz_ = 0;
  asm volatile("" : "+s"(wsz_));
  char* ws = p.ws + wsz_;
  const hf* A = (const hf*)(ws + OFF_A0);
  const hf* W = (const hf*)(ws + OFF_WFNIN);
  hf* ytl = (hf*)(ws + OFF_YTL);
  hf* ytc = (hf*)(ws + OFF_YTC);
  hf* sz = (hf*)(ws + OFF_SZ0);
  for (int t = blockIdx.x; t < 66 * 32; t += gridDim.x) {
    const int mt = t >> 5, nt = t & 31;
    auto arow = [&](int r) -> const hf* {
      int row = (mt < 64) ? (r * 64 + mt) : (SEQ + (mt - 64) * 128 + r);
      return A + (size_t)row * D;
    };
    auto brow = [&](int r) -> const hf* { return W + (size_t)(nt * 128 + r) * D; };
    f16v acc[2][2];
    if (nt < 16) {
      gemm_main2<false>(lds, D, arow, brow, acc);
      gemm_epi<false>(acc, [&](int m0, int n, float a, float b, float c, float d) {
        int col = nt * 128 + n;
        h4 o = mk4(a, b, c, d);
        if (mt < 64) *(h4*)(ytl + ((size_t)col * 64 + mt) * 128 + m0) = o;
        else *(h4*)(ytc + (size_t)col * 256 + (mt - 64) * 128 + m0) = o;
      });
    } else {
      gemm_main2<true>(lds, D, arow, brow, acc);
      gemm_epi<true>(acc, [&](int m, int n0, float a, float b, float c, float d) {
        int row = (mt < 64) ? (m * 64 + mt) : (SEQ + (mt - 64) * 128 + m);
        int col = (nt - 16) * 128 + n0;
        *(h4*)(sz + (size_t)row * 2048 + col) = mk4(silu_f(a), silu_f(b), silu_f(c), silu_f(d));
      });
    }
  }
}

DI void phase_stageA(const Params& p, hf* lds) {
  size_t wsz_ = 0;
  asm volatile("" : "+s"(wsz_));
  char* ws = p.ws + wsz_;
  const hf* ytl = (const hf*)(ws + OFF_YTL);
  const hf* ytc = (const hf*)(ws + OFF_YTC);
  const hf* w1 = (const hf*)(ws + OFF_TW1);
  const hf* w256 = (const hf*)(ws + OFF_T256);
  const float2* tw = (const float2*)(ws + OFF_TWID);
  hf* zt = (hf*)(ws + OFF_ZT);
  hf* vt = (hf*)(ws + OFF_VT);
  const int lane = tidx() & 63, wid = tidx() >> 6, wr = wid >> 1, wc = wid & 1, hh = lane >> 5, l31 = lane & 31;
  for (int t = blockIdx.x; t < 2048 + 64; t += gridDim.x) {
    f16v acc[2][2];
    if (t < 2048) {
      const int mt = t >> 1, nt = t & 1;
      auto arow = [&](int r) -> const hf* { return ytl + (size_t)(mt * 128 + r) * 128; };
      auto brow = [&](int r) -> const hf* { return w1 + (size_t)(nt * 128 + r) * 128; };
      gemm_main2<false>(lds, 128, arow, brow, acc);
      const int k1 = (nt * 2 + wc) * 32 + l31;
#pragma unroll
      for (int i = 0; i < 2; ++i)
#pragma unroll
        for (int q = 0; q < 4; ++q) {
          const int m0 = mt * 128 + wr * 64 + i * 32 + 8 * q + 4 * hh;
          const int col = m0 >> 6, l2 = m0 & 63;
          float zr[4], zi[4];
#pragma unroll
          for (int e = 0; e < 4; ++e) {
            float2 cs = tw[(k1 * (l2 + e)) & 8191];
            float re = acc[i][0][4 * q + e], im = acc[i][1][4 * q + e];
            zr[e] = re * cs.x + im * cs.y;
            zi[e] = im * cs.x - re * cs.y;
          }
          size_t base = (((size_t)k1 * 2048 + col) * 2) * 64 + l2;
          *(h4*)(zt + base) = mk4(zr[0], zr[1], zr[2], zr[3]);
          *(h4*)(zt + base + 64) = mk4(zi[0], zi[1], zi[2], zi[3]);
        }
    } else {
      const int tt = t - 2048, mt = tt >> 2, nt = tt & 3;
      auto arow = [&](int r) -> const hf* { return ytc + (size_t)(mt * 128 + r) * 256; };
      auto brow = [&](int r) -> const hf* { return w256 + (size_t)(nt * 128 + r) * 256; };
      gemm_main2<false>(lds, 256, arow, brow, acc);
      gemm_epi<false>(acc, [&](int m0, int n, float a, float b, float c, float d) {
        int col = mt * 128 + m0, nn = nt * 128 + n;
        int im = nn >> 8, k = nn & 255, g = col >> 8, cc = col & 255;
        *(h4*)(vt + (size_t)(SEQ + k) * 4096 + g * 512 + im * 256 + cc) = mk4(a, b, c, d);
      });
    }
  }
}

DI void phase_stageB(const Params& p, hf* lds) {
  size_t wsz_ = 0;
  asm volatile("" : "+s"(wsz_));
  char* ws = p.ws + wsz_;
  const hf* zt = (const hf*)(ws + OFF_ZT);
  const hf* w2 = (const hf*)(ws + OFF_TW2);
  hf* vt = (hf*)(ws + OFF_VT);
  for (int t = blockIdx.x; t < 2048; t += gridDim.x) {
    f16v acc[2][2];
    auto arow = [&](int r) -> const hf* { return zt + (size_t)(t * 128 + r) * 128; };
    auto brow = [&](int r) -> const hf* { return w2 + (size_t)r * 128; };
    gemm_main2<false>(lds, 128, arow, brow, acc);
    gemm_epi<false>(acc, [&](int m0, int n, float a, float b, float c, float d) {
      int m = t * 128 + m0;
      int k1 = m >> 11, col = m & 2047, im = n >> 6, k2 = n & 63;
      int g = col >> 8, cc = col & 255;
      *(h4*)(vt + (size_t)(k1 + 128 * k2) * 4096 + g * 512 + im * 256 + cc) = mk4(a, b, c, d);
    });
  }
}

DI void phase_group(const Params& p, hf* lds) {
  size_t wsz_ = 0;
  asm volatile("" : "+s"(wsz_));
  char* ws = p.ws + wsz_;
  const hf* vt = (const hf*)(ws + OFF_VT);
  const hf* wg = (const hf*)(ws + OFF_WG);
  hf* sz = (hf*)(ws + OFF_SZ0);
  for (int t = blockIdx.x; t < 66 * 16; t += gridDim.x) {
    const int mt = t >> 4, g = (t >> 1) & 7, nt = t & 1;
    f16v acc[2][2];
    auto arow = [&](int r) -> const hf* { return vt + (size_t)(mt * 128 + r) * 4096 + g * 512; };
    auto brow = [&](int r) -> const hf* { return wg + (size_t)(g * 256 + nt * 128 + r) * 512; };
    gemm_main2<true>(lds, 512, arow, brow, acc);
    gemm_epi<true>(acc, [&](int m, int n0, float a, float b, float c, float d) {
      hf* q = sz + (size_t)(mt * 128 + m) * 2048 + g * 256 + nt * 128 + n0;
      h4 s = *(const h4*)q;
      *(h4*)q = mk4(a * (float)s[0], b * (float)s[1], c * (float)s[2], d * (float)s[3]);
    });
  }
}

DI void phase_outproj(const Params& p, int b, int layer, hf* lds) {
  size_t wsz_ = 0;
  asm volatile("" : "+s"(wsz_));
  char* ws = p.ws + wsz_;
  const hf* A = (const hf*)(ws + (layer == 0 ? OFF_SZ0 : OFF_SZ1));
  const hf* W = (const hf*)(ws + (layer == 0 ? OFF_WFNOUT : OFF_WDNOUT));
  const float* modb = (const float*)(ws + OFF_MOD);
  const int ntile = layer == 0 ? 512 + 128 : 512;
  for (int t = blockIdx.x; t < ntile; t += gridDim.x) {
    f16v acc[2][2];
    if (t < 512) {
      const int mt = t >> 3, nt = t & 7;
      auto arow = [&](int r) -> const hf* { return A + (size_t)(mt * 128 + r) * 2048; };
      auto brow = [&](int r) -> const hf* { return W + (size_t)(nt * 128 + r) * 2048; };
      gemm_main2<true>(lds, 2048, arow, brow, acc);
      gemm_epi<true>(acc, [&](int m, int n0, float a0, float a1, float a2, float a3) {
        int row = mt * 128 + m, col = nt * 128 + n0;
        float* dst = p.out + ((size_t)b * SEQ + row) * D + col;
        const float* src = (layer == 0) ? p.x + ((size_t)b * SEQ + row) * D + col : dst;
        float4 gt = *(const float4*)(modb + (layer * 3 + b) * 3072 + 2048 + col);
        float4 s = *(const float4*)src;
        *(float4*)dst = make_float4(s.x + gt.x * a0, s.y + gt.y * a1, s.z + gt.z * a2, s.w + gt.w * a3);
      });
    } else {
      const int it = t - 512, tile = it >> 3, ksp = it & 7;
      const int mt = 64 + (tile >> 3), nt = tile & 7;
      auto arow = [&](int r) -> const hf* { return A + (size_t)(mt * 128 + r) * 2048 + ksp * 256; };
      auto brow = [&](int r) -> const hf* { return W + (size_t)(nt * 128 + r) * 2048 + ksp * 256; };
      gemm_main2<true>(lds, 256, arow, brow, acc);
      gemm_epi<true>(acc, [&](int m, int n0, float a0, float a1, float a2, float a3) {
        int row = mt * 128 + m - SEQ, col = nt * 128 + n0;
        float* dst = (float*)(ws + OFF_HCTX) + (size_t)row * D + col;
        float4 gt = *(const float4*)(modb + (0 * 3 + 2) * 3072 + 2048 + col);
        unsafeAtomicAdd(dst + 0, gt.x * a0);
        unsafeAtomicAdd(dst + 1, gt.y * a1);
        unsafeAtomicAdd(dst + 2, gt.z * a2);
        unsafeAtomicAdd(dst + 3, gt.w * a3);
      });
    }
  }
}

DI void phase_inproj1(const Params& p, hf* lds) {
  size_t wsz_ = 0;
  asm volatile("" : "+s"(wsz_));
  char* ws = p.ws + wsz_;
  const hf* A = (const hf*)(ws + OFF_QN);
  const hf* W = (const hf*)(ws + OFF_WDNIN);
  hf* pre = (hf*)(ws + OFF_REC);
  hf* sz = (hf*)(ws + OFF_SZ1);
  float* ab = (float*)(ws + OFF_AB);
  for (int t = blockIdx.x; t < 66 * 49; t += gridDim.x) {
    const int mt = t / 49, nt = t % 49;
    f16v acc[2][2];
    auto arow = [&](int r) -> const hf* { return A + (size_t)(mt * 128 + r) * D; };
    auto brow = [&](int r) -> const hf* { return W + (size_t)(nt * 128 + r) * D; };
    gemm_main2<true>(lds, D, arow, brow, acc);
    gemm_epi<true>(acc, [&](int m, int n0, float a, float b, float c, float d) {
      int row = mt * 128 + m, col = nt * 128 + n0;
      if (nt < 32) *(h4*)(pre + (size_t)row * 4096 + col) = mk4(a, b, c, d);
      else if (nt < 48) *(h4*)(sz + (size_t)row * 2048 + (col - 4096)) = mk4(silu_f(a), silu_f(b), silu_f(c), silu_f(d));
      else if (col - 6144 < 32) *(float4*)(ab + (size_t)row * 32 + (col - 6144)) = make_float4(a, b, c, d);
    });
  }
}

DI void phase_conv(const Params& p, char* ldsc) {
  size_t wsz_ = 0;
  asm volatile("" : "+s"(wsz_));
  char* ws = p.ws + wsz_;
  const int tid = tidx();
  const hf* pre = (const hf*)(ws + OFF_REC);
  hf* tile = (hf*)ldsc;
  const int ch8 = tid & 15, tk = tid >> 4;
  for (int it = blockIdx.x; it < 132 * 32; it += gridDim.x) {
    const int rr = it >> 5, cb = it & 31;
    const bool isctx = rr >= 128;
    const int T = isctx ? CTXL : SEQ;
    const int t0 = isctx ? (rr - 128) * 64 : rr * 64;
    int chbase, kind, head, dvo = 0;
    if (cb < 8) { kind = 0; head = cb; chbase = cb * 128; }
    else if (cb < 16) { kind = 1; head = cb - 8; chbase = 1024 + (cb - 8) * 128; }
    else { kind = 2; head = (cb - 16) >> 1; dvo = ((cb - 16) & 1) * 128; chbase = 2048 + (cb - 16) * 128; }
    const int ch = chbase + ch8 * 8;
    float w[9][8];
#pragma unroll
    for (int k = 0; k < 9; ++k) {
      float4 wa = *(const float4*)(p.dn_conv + k * 4096 + ch), wb = *(const float4*)(p.dn_conv + k * 4096 + ch + 4);
      w[k][0] = wa.x; w[k][1] = wa.y; w[k][2] = wa.z; w[k][3] = wa.w;
      w[k][4] = wb.x; w[k][5] = wb.y; w[k][6] = wb.z; w[k][7] = wb.w;
    }
    auto ldw = [&](int di, int col) -> h8 {
      int row;
      bool ok;
      if (!isctx) {
        int r2 = rr + di - 1;
        ok = (r2 >= 0) && (r2 < 128) && (col >= 0) && (col < 64);
        row = r2 * 64 + col;
      } else {
        int p2 = t0 + col;
        ok = (di == 1) && (p2 >= 0) && (p2 < 256);
        row = SEQ + p2;
      }
      h8 v;
#pragma unroll
      for (int e = 0; e < 8; ++e) v[e] = (hf)0.f;
      if (ok) v = *(const h8*)(pre + (size_t)row * 4096 + ch);
      return v;
    };
    const int c0 = tk * 4;
    h8 win[3][6];
#pragma unroll
    for (int di = 0; di < 3; ++di)
#pragma unroll
      for (int cx = 0; cx < 6; ++cx) win[di][cx] = ldw(di, c0 - 1 + cx);
#pragma unroll
    for (int pp = 0; pp < 4; ++pp) {
      const int cc = c0 + pp;
      float y[8];
#pragma unroll
      for (int e = 0; e < 8; ++e) y[e] = 0.f;
#pragma unroll
      for (int di = 0; di < 3; ++di) {
#pragma unroll
        for (int e = 0; e < 8; ++e)
          y[e] += (float)win[di][pp][e] * w[di * 3 + 0][e] + (float)win[di][pp + 1][e] * w[di * 3 + 1][e] + (float)win[di][pp + 2][e] * w[di * 3 + 2][e];
      }
      float ss = 0.f;
#pragma unroll
      for (int e = 0; e < 8; ++e) { y[e] = silu_f(y[e]); ss += y[e] * y[e]; }
      if (kind < 2) {
        ss += __shfl_xor(ss, 1);
        ss += __shfl_xor(ss, 2);
        ss += __shfl_xor(ss, 4);
        ss += __shfl_xor(ss, 8);
        float sc = rsqrtf(ss + EPS) * (kind == 0 ? 0.08838834764831845f : 1.f);
#pragma unroll
        for (int e = 0; e < 8; ++e) y[e] *= sc;
      }
      h8 o;
#pragma unroll
      for (int e = 0; e < 8; ++e) o[e] = (hf)y[e];
      if (kind < 2) {
        hf* base = (hf*)(ws + (kind == 0 ? OFF_QN : OFF_KN)) + (isctx ? (size_t)8 * SEQ * 128 : 0);
        *(h8*)(base + ((size_t)head * T + t0 + cc) * 128 + ch8 * 8) = o;
      }
      if (kind >= 1) {
#pragma unroll
        for (int e = 0; e < 8; ++e) tile[(ch8 * 8 + e) * 72 + cc] = o[e];
      }
    }
    if (kind >= 1) {
      __syncthreads();
      const int chunk = rr;
      hf* base;
      if (kind == 1) base = (hf*)(ws + OFF_KNT) + ((size_t)(head * 132 + chunk) * 128) * 64;
      else base = (hf*)(ws + OFF_VTT) + ((size_t)(head * 132 + chunk) * 256 + dvo) * 64;
#pragma unroll
      for (int k = 0; k < 4; ++k) {
        int q = tid + 256 * k;
        int c = q >> 3, t8 = q & 7;
        h8 v = *(const h8*)(tile + c * 72 + t8 * 8);
        *(h8*)(base + (size_t)c * 64 + t8 * 8) = v;
      }
      __syncthreads();
    }
  }
}

DI void step_geom(int s, int d, bool& isctx, int& T, int& t0) {
  isctx = s < 4;
  int oc = isctx ? (d ? 3 - s : s) : (d ? 127 - (s - 4) : (s - 4));
  T = isctx ? CTXL : SEQ;
  t0 = oc * 64;
}
DI int step_chunk(int s, int d) {
  return (s < 4) ? 128 + (d ? 3 - s : s) : (d ? 127 - (s - 4) : (s - 4));
}

DI void phase_dprep(const Params& p, char* ldsc) {
  size_t wsz_ = 0;
  asm volatile("" : "+s"(wsz_));
  char* ws = p.ws + wsz_;
  const int tid = tidx(), lane = tid & 63, wid = tid >> 6, hh = lane >> 5, l31 = lane & 31;
  hf* kS = (hf*)ldsc;
  hf* qS = kS + 64 * 136;
  float* Ns = (float*)(qS + 64 * 136);
  hf* Tbs = (hf*)(Ns + 64 * 68);
  hf* Tws = Tbs + 64 * 72;
  float* gcs = (float*)(Tws + 64 * 72);
  float* bts = gcs + 64;
  const float* ab = (const float*)(ws + OFF_AB);
  for (int it = blockIdx.x; it < 8 * 2 * NSTEP; it += gridDim.x) {
    const int h = it / (2 * NSTEP), d = (it / NSTEP) & 1, s = it % NSTEP;
    bool isctx; int T, t0;
    step_geom(s, d, isctx, T, t0);
    const int row0 = isctx ? SEQ + t0 : t0;
    char* rec = ws + OFF_REC + (size_t)it * REC_BYTES;
    const hf* qn = (const hf*)(ws + OFF_QN) + (isctx ? (size_t)8 * SEQ * 128 : 0) + ((size_t)h * T + t0) * 128;
    const hf* kn = (const hf*)(ws + OFF_KN) + (isctx ? (size_t)8 * SEQ * 128 : 0) + ((size_t)h * T + t0) * 128;
    const hf* knt = (const hf*)(ws + OFF_KNT) + ((size_t)(h * 132 + step_chunk(s, d)) * 128) * 64;
    if (tid < 64) {
      const int pp = tid;
      float a = ab[(size_t)(row0 + pp) * 32 + d * 8 + h], bb = ab[(size_t)(row0 + pp) * 32 + 16 + d * 8 + h];
      float xx = a + p.dn_dt_bias[d * 8 + h];
      float sp = fmaxf(xx, 0.f) + log1pf(expf(-fabsf(xx)));
      float g = -expf(p.dn_a_log[d * 8 + h]) * sp;
      float beta = 1.f / (1.f + expf(-bb));
      float v = g;
#pragma unroll
      for (int o = 1; o < 64; o <<= 1) {
        float nb = d ? __shfl_down(v, o) : __shfl_up(v, o);
        bool ok = d ? (pp + o < 64) : (pp >= o);
        if (ok) v += nb;
      }
      gcs[pp] = v;
      bts[pp] = beta;
    }
#pragma unroll
    for (int k = 0; k < 4; ++k) {
      int q = tid + 256 * k;
      int r = q >> 4, c16 = q & 15;
      *(uint4*)(kS + r * 136 + c16 * 8) = ldg4(kn + (size_t)r * 128 + c16 * 8);
      *(uint4*)(qS + r * 136 + c16 * 8) = ldg4(qn + (size_t)r * 128 + c16 * 8);
    }
    __syncthreads();
    const float glast = d ? gcs[0] : gcs[63];
    {
      const int ta = wid >> 1, tb = wid & 1;
      f16v akk, aqk;
#pragma unroll
      for (int r = 0; r < 16; ++r) { akk[r] = 0.f; aqk[r] = 0.f; }
#pragma unroll
      for (int ks = 0; ks < 8; ++ks) {
        h8 fa = *(const h8*)(kS + (ta * 32 + l31) * 136 + ks * 16 + hh * 8);
        h8 fb = *(const h8*)(kS + (tb * 32 + l31) * 136 + ks * 16 + hh * 8);
        h8 fq = *(const h8*)(qS + (tb * 32 + l31) * 136 + ks * 16 + hh * 8);
        akk = mfma16(fa, fb, akk);
        aqk = mfma16(fa, fq, aqk);
      }
      const int pb = tb * 32 + l31;
      const float gb = gcs[pb];
      h8 f0, f1;
#pragma unroll
      for (int r = 0; r < 16; ++r) {
        const int pa = ta * 32 + rowmap(r, hh);
        const float ga = gcs[pa];
        bool strict = d ? (pb > pa) : (pb < pa);
        if (strict) {
          int i = d ? 63 - pa : pa, j = d ? 63 - pb : pb;
          Ns[i * 68 + j] = bts[pa] * akk[r] * __expf(ga - gb);
        }
        bool le = d ? (pa >= pb) : (pa <= pb);
        float v = le ? aqk[r] * __expf(gb - ga) : 0.f;
        if (r < 8) f0[r] = (hf)v; else f1[r - 8] = (hf)v;
      }
      if (!isctx) {
        int slot = (ta == tb) ? ta : ((d ? (ta > tb) : (ta < tb)) ? 2 : -1);
        if (slot >= 0) {
          hf* dst = (hf*)(rec + 16384 + 8192);
          *(h8*)(dst + ((slot * 2 + 0) * 64 + lane) * 8) = f0;
          *(h8*)(dst + ((slot * 2 + 1) * 64 + lane) * 8) = f1;
        }
      }
    }
    __syncthreads();
    float* Tf = (float*)kS;
    float* Xf = Tf + 64 * 68;
    if (wid < 2) {
      const int base = wid * 32, cl = lane & 31;
      int zofs = 0;
      asm volatile("" : "+v"(zofs));
      const float* Nz = Ns + zofs + base * 68 + base;
      float nrow[32];
#pragma unroll
      for (int i = 1; i < 32; ++i) nrow[i] = Nz[i * 68 + cl];
      float tt[32];
#pragma unroll
      for (int i = 0; i < 32; ++i) {
        float a = (i == cl) ? 1.f : 0.f;
        float nr = (i > 0) ? nrow[i] : 0.f;
        if (i > 0) asm volatile("" : "+v"(nr) : "v"(tt[i - 1]));
#pragma unroll
        for (int j = 0; j < i; ++j)
          a -= __builtin_bit_cast(float, __builtin_amdgcn_readlane(__builtin_bit_cast(int, nr), j)) * tt[j];
        tt[i] = a;
      }
      if (lane < 32) {
#pragma unroll
        for (int i = 0; i < 32; ++i) Tf[(base + i) * 68 + base + cl] = tt[i];
      }
    } else if (wid == 2) {
      float* vec = (float*)(rec + 16384 + 8192 + 6144);
      vec[lane] = __expf(gcs[lane]);
      vec[64 + lane] = __expf(glast - gcs[lane]);
      if (lane == 0) vec[128] = __expf(glast);
    }
    __syncthreads();
    {
      const int i = tid >> 3, c4 = (tid & 7) * 4;
      float x0 = 0.f, x1 = 0.f, x2 = 0.f, x3 = 0.f;
#pragma unroll 8
      for (int j = 0; j < 32; ++j) {
        const float n = Ns[(32 + i) * 68 + j];
        const float4 t = *(const float4*)(Tf + j * 68 + c4);
        x0 += n * t.x; x1 += n * t.y; x2 += n * t.z; x3 += n * t.w;
      }
      *(float4*)(Xf + i * 36 + c4) = make_float4(x0, x1, x2, x3);
    }
    __syncthreads();
    {
      const int i = tid >> 3, c4 = (tid & 7) * 4;
      float y0 = 0.f, y1 = 0.f, y2 = 0.f, y3 = 0.f;
#pragma unroll 8
      for (int k = 0; k < 32; ++k) {
        const float t = (k <= i) ? Tf[(32 + i) * 68 + 32 + k] : 0.f;
        const float4 x = *(const float4*)(Xf + k * 36 + c4);
        y0 += t * x.x; y1 += t * x.y; y2 += t * x.z; y3 += t * x.w;
      }
      *(float4*)(Tf + (32 + i) * 68 + c4) = make_float4(-y0, -y1, -y2, -y3);
      *(float4*)(Tf + i * 68 + 32 + c4) = make_float4(0.f, 0.f, 0.f, 0.f);
    }
    __syncthreads();
    {
      const int i = tid >> 2, c0 = (tid & 3) * 16;
      const int pi = d ? 63 - i : i;
#pragma unroll
      for (int e = 0; e < 16; ++e) {
        const int c = c0 + e, pc = d ? 63 - c : c;
        const float v = Tf[i * 68 + c] * bts[pc];
        Tbs[pi * 72 + pc] = (hf)v;
        Tws[pi * 72 + pc] = (hf)(v * __expf(gcs[pc]));
      }
    }
    __syncthreads();
#pragma unroll
    for (int k = 0; k < 2; ++k) {
      int q = tid + 256 * k;
      int r = q >> 3, c8 = q & 7;
      *(uint4*)(rec + 16384 + (size_t)(r * 64 + c8 * 8) * 2) = *(const uint4*)(Tbs + r * 72 + c8 * 8);
    }
    {
      const int dt = wid;
      h8 fa[4];
#pragma unroll
      for (int su = 0; su < 4; ++su) fa[su] = *(const h8*)(knt + (size_t)(dt * 32 + l31) * 64 + su * 16 + hh * 8);
#pragma unroll
      for (int jt = 0; jt < 2; ++jt) {
        f16v a;
#pragma unroll
        for (int r = 0; r < 16; ++r) a[r] = 0.f;
#pragma unroll
        for (int su = 0; su < 4; ++su) {
          h8 fb = *(const h8*)(Tws + (jt * 32 + l31) * 72 + su * 16 + hh * 8);
          a = mfma16(fa[su], fb, a);
        }
        h8 f0, f1;
#pragma unroll
        for (int r = 0; r < 8; ++r) { f0[r] = (hf)(-a[r]); f1[r] = (hf)(-a[8 + r]); }
        hf* dst = (hf*)rec;
        *(h8*)(dst + (((dt * 2 + jt) * 2 + 0) * 64 + lane) * 8) = f0;
        *(h8*)(dst + (((dt * 2 + jt) * 2 + 1) * 64 + lane) * 8) = f1;
      }
    }
    __syncthreads();
  }
}

DI void phase_scan(const Params& p, char* ldsc) {
  size_t wsz_ = 0;
  asm volatile("" : "+s"(wsz_));
  char* ws = p.ws + wsz_;
  const int tid = tidx(), lane = tid & 63, wid = tid >> 6, hh = lane >> 5, l31 = lane & 31;
  const int rw = wid & 1;
  const bool roleB = wid >= 2;
  hf* wS = (hf*)ldsc;
  hf* TbS = wS + 8192;
  hf* qS = TbS + 64 * 64;
  hf* ktS = qS + 64 * 128;
  hf* qkS = ktS + 128 * 64;
  float* vecS = (float*)(qkS + 3072);
  hf* VfS = (hf*)(vecS + 256);
  hf* SfS = VfS + 4 * 64 * 8;
  for (int it = blockIdx.x; it < 128; it += gridDim.x) {
    const int h = it >> 4, d = (it >> 3) & 1, dv8 = it & 7;
    const int dv = dv8 * 32 + l31;
    const char* recb = ws + OFF_REC + (size_t)((h * 2 + d) * NSTEP) * REC_BYTES;
    hf* O = (hf*)(ws + (d ? OFF_O1 : OFF_O0));
    f16v Sd;
#pragma unroll
    for (int r = 0; r < 16; ++r) Sd[r] = 0.f;
    {
      h8 z;
#pragma unroll
      for (int j = 0; j < 8; ++j) z[j] = (hf)0.f;
      *(h8*)(SfS + ((wid * 2 + 0) * 64 + lane) * 8) = z;
      *(h8*)(SfS + ((wid * 2 + 1) * 64 + lane) * 8) = z;
    }
    h8 vt[4];
    const int wid_s = __builtin_amdgcn_readfirstlane(wid);
    auto dma = [&](const void* src, char* dstbase, int L) {
      __builtin_amdgcn_global_load_lds((const unsigned*)src, (unsigned*)(dstbase + (size_t)(L - tid + wid_s * 64) * 16), 16, 0, 0);
    };
    const int offT = (tid >> 3) * 128 + (((tid & 7) ^ ((tid >> 4) & 7)) * 16);
    const int offQ = (tid >> 4) * 256 + (((tid & 15) ^ ((tid >> 4) & 15)) * 16);
    auto issueG1 = [&](int s) {
      bool isctx; int T, t0;
      step_geom(s, d, isctx, T, t0);
      const char* rec = recb + (size_t)s * REC_BYTES;
      const char* qn = (const char*)((const hf*)(ws + OFF_QN) + (isctx ? (size_t)8 * SEQ * 128 : 0) + ((size_t)h * T + t0) * 128);
#pragma unroll
      for (int k = 0; k < 4; ++k) dma(rec + tid * 16 + k * 4096, (char*)wS, tid + 256 * k);
#pragma unroll
      for (int k = 0; k < 2; ++k) dma(rec + 16384 + offT + k * 4096, (char*)TbS, tid + 256 * k);
#pragma unroll
      for (int k = 0; k < 4; ++k) dma(qn + offQ + k * 4096, (char*)qS, tid + 256 * k);
    };
    auto issueG2 = [&](int s) {
      const char* rec = recb + (size_t)s * REC_BYTES;
      const char* knt = (const char*)((const hf*)(ws + OFF_KNT) + ((size_t)(h * 132 + step_chunk(s, d)) * 128) * 64);
#pragma unroll
      for (int k = 0; k < 4; ++k) dma(knt + offT + k * 4096, (char*)ktS, tid + 256 * k);
      dma(rec + 24576 + tid * 16, (char*)qkS, tid);
      if (tid < 192) dma(rec + 24576 + (tid + 256) * 16, (char*)qkS, tid + 256);
    };
    auto loadV = [&](int s) {
      const hf* vtt = (const hf*)(ws + OFF_VTT) + ((size_t)(h * 132 + step_chunk(s, d)) * 256 + dv) * 64;
#pragma unroll
      for (int su = 0; su < 4; ++su) vt[su] = *(const h8*)(vtt + su * 16 + hh * 8);
    };
    issueG1(0);
    if (!roleB) loadV(0);
    __syncthreads();
#pragma unroll 1
    for (int s = 0; s < NSTEP; ++s) {
      bool isctx; int T, t0;
      step_geom(s, d, isctx, T, t0);
      issueG2(s);
      h8 vf[4];
      f16v ao;
#pragma unroll
      for (int r = 0; r < 16; ++r) ao[r] = 0.f;
      if (!roleB) {
        auto ldA = [&](int i) -> h8 {
          if (i < 4) return *(const h8*)(TbS + (rw * 32 + l31) * 64 + (((i * 2 + hh) ^ ((l31 >> 1) & 7)) * 8));
          const int dt = (i - 4) >> 1, sp = (i - 4) & 1;
          return *(const h8*)(wS + (((dt * 2 + rw) * 2 + sp) * 64 + lane) * 8);
        };
        h8 c0 = ldA(0);
#pragma unroll
        for (int i = 0; i < 12; ++i) {
          h8 n0;
          if (i + 1 < 12) n0 = ldA(i + 1);
          __builtin_amdgcn_sched_barrier(0);
          h8 bf;
          if (i < 4) bf = vt[i];
          else bf = *(const h8*)(SfS + ((i - 4) * 64 + lane) * 8);
          ao = mfma16(c0, bf, ao);
          if (i == 3 && s + 1 < NSTEP) loadV(s + 1);
          __builtin_amdgcn_sched_barrier(0);
          if (i + 1 < 12) c0 = n0;
        }
#pragma unroll
        for (int sp = 0; sp < 2; ++sp) *(h8*)(VfS + ((rw * 2 + sp) * 64 + lane) * 8) = cvt8(ao, sp);
      } else if (!isctx) {
        auto ldQ = [&](int i) -> h8 {
          const hf* qrow = qS + (rw * 32 + l31) * 128 + hh * 4;
          h4 lo = *(const h4*)(qrow + (((2 * i) ^ (l31 & 15)) * 8)), hi = *(const h4*)(qrow + (((2 * i + 1) ^ (l31 & 15)) * 8));
          return __builtin_shufflevector(lo, hi, 0, 1, 2, 3, 4, 5, 6, 7);
        };
        h8 q0 = ldQ(0);
#pragma unroll
        for (int i = 0; i < 8; ++i) {
          h8 n0;
          if (i + 1 < 8) n0 = ldQ(i + 1);
          __builtin_amdgcn_sched_barrier(0);
          ao = mfma16(*(const h8*)(SfS + (i * 64 + lane) * 8), q0, ao);
          __builtin_amdgcn_sched_barrier(0);
          if (i + 1 < 8) q0 = n0;
        }
      }
      if (!roleB && s + 1 < NSTEP) asm volatile("s_waitcnt vmcnt(4) lgkmcnt(0)" ::: "memory");
      else asm volatile("s_waitcnt vmcnt(0) lgkmcnt(0)" ::: "memory");
      __builtin_amdgcn_s_barrier();
      if (s + 1 < NSTEP) issueG1(s + 1);
      __builtin_amdgcn_sched_barrier(0);
#pragma unroll
      for (int f = 0; f < 4; ++f) vf[f] = *(const h8*)(VfS + (f * 64 + lane) * 8);
      if (roleB && !isctx) {
        const float egi = vecS[rw * 32 + l31];
#pragma unroll
        for (int r = 0; r < 16; ++r) ao[r] *= egi;
#pragma unroll
        for (int jt = 0; jt < 2; ++jt) {
          int slot = (jt == rw) ? jt : ((d ? (jt > rw) : (jt < rw)) ? 2 : -1);
          if (slot >= 0) {
#pragma unroll
            for (int sp = 0; sp < 2; ++sp) {
              h8 fk = *(const h8*)(qkS + ((slot * 2 + sp) * 64 + lane) * 8);
              ao = mfma16(vf[jt * 2 + sp], fk, ao);
            }
          }
        }
        hf* dst = O + (size_t)(t0 + rw * 32 + l31) * 2048 + h * 256 + dv8 * 32 + 4 * hh;
#pragma unroll
        for (int q = 0; q < 4; ++q) *(h4*)(dst + 8 * q) = mk4(ao[4 * q], ao[4 * q + 1], ao[4 * q + 2], ao[4 * q + 3]);
      }
      __builtin_amdgcn_sched_barrier(0);
      {
        const float egl = vecS[128];
        h8 vk[4];
#pragma unroll
        for (int jt = 0; jt < 2; ++jt)
#pragma unroll
          for (int sp = 0; sp < 2; ++sp) {
            h8 f;
#pragma unroll
            for (int j = 0; j < 8; ++j) f[j] = (hf)((float)vf[jt * 2 + sp][j] * vecS[64 + jt * 32 + rowmap(8 * sp + j, hh)]);
            vk[jt * 2 + sp] = f;
          }
#pragma unroll
        for (int r = 0; r < 16; ++r) Sd[r] *= egl;
        {
          const hf* krow = ktS + (wid * 32 + l31) * 64 + hh * 4;
          const int ksw = (l31 >> 1) & 7;
#pragma unroll
          for (int js = 0; js < 4; ++js) {
            h4 lo = *(const h4*)(krow + (((2 * js) ^ ksw) * 8)), hi = *(const h4*)(krow + (((2 * js + 1) ^ ksw) * 8));
            h8 fk = __builtin_shufflevector(lo, hi, 0, 1, 2, 3, 4, 5, 6, 7);
            Sd = mfma16(fk, vk[js], Sd);
          }
          *(h8*)(SfS + ((wid * 2 + 0) * 64 + lane) * 8) = cvt8(Sd, 0);
          *(h8*)(SfS + ((wid * 2 + 1) * 64 + lane) * 8) = cvt8(Sd, 1);
        }
      }
      __syncthreads();
    }
  }
}

DI void phase_onorm(const Params& p) {
  size_t wsz_ = 0;
  asm volatile("" : "+s"(wsz_));
  char* ws = p.ws + wsz_;
  const int tid = tidx(), lane = tid & 63, wid = tid >> 6;
  const hf* O0 = (const hf*)(ws + OFF_O0);
  const hf* O1 = (const hf*)(ws + OFF_O1);
  hf* sz = (hf*)(ws + OFF_SZ1);
  for (int it = blockIdx.x; it < SEQ / 4; it += gridDim.x) {
    const int row = it * 4 + wid;
#pragma unroll
    for (int k = 0; k < 4; ++k) {
      const int e = k * 512 + lane * 8;
      h8 o = *(const h8*)(O0 + (size_t)row * 2048 + e);
      h8 o1 = *(const h8*)(O1 + (size_t)row * 2048 + e);
      float v[8], ss = 0.f;
#pragma unroll
      for (int j = 0; j < 8; ++j) { v[j] = (float)o[j] + (float)o1[j]; ss += v[j] * v[j]; }
#pragma unroll
      for (int m = 1; m <= 16; m <<= 1) ss += __shfl_xor(ss, m);
      const float rstd = rsqrtf(ss * (1.f / 256.f) + EPS);
      const int dvv = e & 255;
      float4 g0 = *(const float4*)(p.dn_norm_g + dvv), g1 = *(const float4*)(p.dn_norm_g + dvv + 4);
      float gg[8] = {g0.x, g0.y, g0.z, g0.w, g1.x, g1.y, g1.z, g1.w};
      h8 z = *(const h8*)(sz + (size_t)row * 2048 + e);
      h8 r;
#pragma unroll
      for (int j = 0; j < 8; ++j) r[j] = (hf)((float)(hf)(v[j] * rstd * gg[j]) * (float)z[j]);
      *(h8*)(sz + (size_t)row * 2048 + e) = r;
    }
  }
}

DI void phase_final(const Params& p, int b) {
  const int tid = tidx(), lane = tid & 63, wid = tid >> 6;
  for (int it = blockIdx.x; it < SEQ / 4; it += gridDim.x) {
    float* row = p.out + ((size_t)b * SEQ + it * 4 + wid) * D;
    float4 v[4];
    float ss = 0.f;
#pragma unroll
    for (int k = 0; k < 4; ++k) {
      v[k] = *(const float4*)(row + k * 256 + lane * 4);
      ss += v[k].x * v[k].x + v[k].y * v[k].y + v[k].z * v[k].z + v[k].w * v[k].w;
    }
#pragma unroll
    for (int o = 32; o >= 1; o >>= 1) ss += __shfl_xor(ss, o);
    const float rstd = rsqrtf(ss * (1.f / 1024.f) + EPS);
#pragma unroll
    for (int k = 0; k < 4; ++k) {
      float4 g = *(const float4*)(p.final_g + k * 256 + lane * 4);
      *(float4*)(row + k * 256 + lane * 4) = make_float4(v[k].x * rstd * g.x, v[k].y * rstd * g.y, v[k].z * rstd * g.z, v[k].w * rstd * g.w);
    }
  }
}


#define XB_TMO      128
#define XB_XCNT(j)  (256  + 64 * (j))
#define XB_XSUB(j)  (1280 + 64 * (j))
#define XB_XGEN(j)  (2304 + 64 * (j))
#define XB_TOP      3328
#define XB_TOPGEN   3392
#define XCD_BAR_WORDS 3456
#define XB_SPIN_CAP (1u << 18)
#define LAS __attribute__((address_space(3)))
DI unsigned xb_ld(unsigned* p) { return __hip_atomic_load(p, __ATOMIC_RELAXED, __HIP_MEMORY_SCOPE_AGENT); }
DI unsigned xb_add(unsigned* p, unsigned v) { return __hip_atomic_fetch_add(p, v, __ATOMIC_RELAXED, __HIP_MEMORY_SCOPE_AGENT); }
DI unsigned xb_xcc_id() { return (unsigned)__builtin_amdgcn_s_getreg((3 << 11) | 20) & 0xFu; }
#define XB_SPIN(cond, bar) do { unsigned _sp = 0; while (cond) { __builtin_amdgcn_s_sleep(1); \
    if ((++_sp & 255u) == 0u) { if (xb_ld(&(bar)[XB_TMO])) break; if (_sp > XB_SPIN_CAP) { atomicAdd(&(bar)[XB_TMO], 1u); break; } } } } while (0)
struct XcdBarrier { unsigned* bar; unsigned x; volatile LAS unsigned* st; };
DI XcdBarrier xcd_barrier_post(unsigned* bar, volatile LAS unsigned* st) {
  XcdBarrier b; b.bar = bar; b.x = xb_xcc_id(); b.st = st;
  if (threadIdx.x == 0) (void)xb_add(&bar[XB_XCNT(b.x)], 1u);
  return b;
}
DI void xcd_barrier_complete(unsigned* bar, unsigned x, unsigned& nloc, unsigned& nx) {
  const unsigned G = gridDim.x * gridDim.y * gridDim.z;
  unsigned sum, cnt, mine, sp = 0u;
  for (;;) {
    sum = 0u; cnt = 0u; mine = 0u;
#pragma unroll
    for (unsigned j = 0; j < 16; ++j) { const unsigned c = xb_ld(&bar[XB_XCNT(j)]); sum += c; cnt += (c > 0u) ? 1u : 0u; mine = (j == x) ? c : mine; }
    if (sum == G) break;
    __builtin_amdgcn_s_sleep(1);
    if ((++sp & 255u) == 0u) { if (xb_ld(&bar[XB_TMO])) break; if (sp > XB_SPIN_CAP) { atomicAdd(&bar[XB_TMO], 1u); break; } }
  }
  nloc = mine > 0u ? mine : 1u; nx = cnt > 0u ? cnt : 1u;
}
DI void xcd_barrier(const XcdBarrier& b) {
  asm volatile("s_waitcnt vmcnt(0)" ::: "memory");
  __syncthreads();
  if (threadIdx.x == 0) {
    unsigned* bar = b.bar;
    __builtin_amdgcn_s_waitcnt(0);
    unsigned nloc = b.st[0], nx = b.st[1];
    if (nloc == 0u) { xcd_barrier_complete(bar, b.x, nloc, nx); b.st[0] = nloc; b.st[1] = nx; }
    const unsigned old = xb_add(&bar[XB_XSUB(b.x)], 1u);
    const unsigned gen = old / nloc;
    if (old + 1u == (gen + 1u) * nloc) {
      __builtin_amdgcn_fence(__ATOMIC_RELEASE, "agent");
      asm volatile("s_waitcnt vmcnt(0)" ::: "memory");
      const unsigned og = xb_add(&bar[XB_TOP], 1u);
      const unsigned tg = og / nx;
      if (og + 1u == (tg + 1u) * nx) xb_add(&bar[XB_TOPGEN], 1u);
      else XB_SPIN(xb_ld(&bar[XB_TOPGEN]) == tg, bar);
      __builtin_amdgcn_fence(__ATOMIC_ACQUIRE, "agent");
      xb_add(&bar[XB_XGEN(b.x)], 1u);
      asm volatile("s_waitcnt vmcnt(0)" ::: "memory");
    } else {
      XB_SPIN(xb_ld(&bar[XB_XGEN(b.x)]) == gen, bar);
      __builtin_amdgcn_fence(__ATOMIC_ACQUIRE, "agent");
      asm volatile("s_waitcnt vmcnt(0)" ::: "memory");
    }
  }
  __syncthreads();
}

#define PROBE_DUP (-1)
constexpr int NPHASE = 1 + 14 + 13;
#define PROBE_REP_MASK 0
#define PROBE_REP_N 2
#define PROBE_XSYNC 0

__global__ void __launch_bounds__(256, 2) fwd_megakernel(Params p) {
  extern __shared__ __attribute__((aligned(16))) char lds[];
  cg::grid_group grid = cg::this_grid();
  volatile LAS unsigned* xbst = (volatile LAS unsigned*)(lds + LDS_BYTES - 16);
  if (threadIdx.x == 0) { xbst[0] = 0u; xbst[1] = 0u; }
  __syncthreads();
  XcdBarrier xb = xcd_barrier_post((unsigned*)(p.ws + OFF_BAR), xbst);
  for (int ph = p.ph_lo; ph < p.ph_hi; ++ph) {
    if (ph > p.ph_lo) {
      if (p.ph_lo < 0) grid.sync();
      xcd_barrier(xb);
      for (int xs = 0; xs < PROBE_XSYNC; ++xs) xcd_barrier(xb);
    }
#ifdef ONLY
    const int b = 0, q = ONLY; if (ONLY < 0) { phase_prep(p, lds, 0); continue; }
#else
    if (ph == 0) { phase_prep(p, lds, 0); continue; }
    const int idx = ph - 1;
    const int b = idx <= 13 ? 0 : 1, q = idx <= 13 ? idx : idx - 13;
    if (idx == 13) { phase_normmod(p, 1, 0); phase_prep(p, lds, 1); }
#endif
    for (int rep = 0; rep < ((PROBE_REP_MASK >> q) & 1 ? PROBE_REP_N : 1); ++rep)
    switch (q) {
      case 0: phase_normmod(p, b, 0); phase_prep(p, lds, 1); break;
      case 1: phase_gemm1(p, (hf*)lds); break;
      case 2: phase_stageA(p, (hf*)lds); break;
      case 3: phase_stageB(p, (hf*)lds); break;
      case 4: phase_group(p, (hf*)lds); break;
      case 5: phase_outproj(p, b, 0, (hf*)lds); break;
      case 6: phase_normmod(p, b, 1); break;
      case 7: phase_inproj1(p, (hf*)lds); break;
      case 8: phase_conv(p, lds); break;
      case 9: phase_dprep(p, lds); break;
      case 10: phase_scan(p, lds); break;
      case 11: phase_onorm(p); break;
      case 12: phase_outproj(p, b, 1, (hf*)lds); break;
      case 13: phase_final(p, b); break;
    }
  }
}

extern "C" void kernel_launch(void* const* d_in, const int* in_sizes, int n_in, void* d_out, int out_size, void* d_ws,
                              size_t ws_size, hipStream_t stream) {
  static int grid_blocks = 0;
  if (!grid_blocks) {
    int dev = 0, cus = 0, per_cu = 0;
    hipGetDevice(&dev);
    hipDeviceGetAttribute(&cus, hipDeviceAttributeMultiprocessorCount, dev);
    hipFuncSetAttribute((const void*)fwd_megakernel, hipFuncAttributeMaxDynamicSharedMemorySize, LDS_BYTES);
    hipOccupancyMaxActiveBlocksPerMultiprocessor(&per_cu, (const void*)fwd_megakernel, 256, LDS_BYTES);
    if (per_cu < 1) per_cu = 1;
    if (per_cu > 2) per_cu = 2;
    grid_blocks = cus * per_cu;
    if (ws_size < WS_NEED) fprintf(stderr, "workspace too small: %zu < %zu\n", ws_size, (size_t)WS_NEED);
  }
  Params p{};
  const float** f = (const float**)&p;
  for (int i = 0; i < 17; ++i) f[i] = (const float*)d_in[i];
  p.out = (float*)d_out;
  p.ws = (char*)d_ws;
  p.ph_lo = 0;
  p.ph_hi = NPHASE;
  void* args[] = {&p};
  (void)hipMemsetAsync((char*)d_ws + OFF_BAR, 0, XCD_BAR_WORDS * 4, stream);
  hipError_t e = hipLaunchCooperativeKernel((const void*)fwd_megakernel, dim3(grid_blocks), dim3(256), args, LDS_BYTES, stream);
  if (e != hipSuccess) fprintf(stderr, "cooperative launch failed: %s (grid %d)\n", hipGetErrorString(e), grid_blocks);
}
```

```cpp
#include <hip/hip_runtime.h>
#include <hip/hip_cooperative_groups.h>
#include <cstdio>
namespace cg = cooperative_groups;

typedef _Float16 hf;
typedef hf h8 __attribute__((ext_vector_type(8)));
typedef hf h4 __attribute__((ext_vector_type(4)));
typedef hf h2 __attribute__((ext_vector_type(2)));
typedef float f16v __attribute__((ext_vector_type(16)));

#define DI __device__ __forceinline__

constexpr int D = 1024, SEQ = 8192, CTXL = 256, ROWS = SEQ + CTXL;
constexpr float EPS = 1e-6f;
constexpr size_t MiB = 1ull << 20;
constexpr size_t OFF_WDNIN = 0;
constexpr size_t OFF_WDNOUT = 13 * MiB;
constexpr size_t OFF_TW1 = 17 * MiB;
constexpr size_t OFF_TW2 = OFF_TW1 + 65536;
constexpr size_t OFF_T256 = OFF_TW2 + 32768;
constexpr size_t OFF_TWID = OFF_T256 + 262144;
constexpr size_t OFF_MOD = OFF_TWID + 65536;
constexpr size_t OFF_HCTX = 18 * MiB;
constexpr size_t OFF_AB = 19 * MiB;
constexpr size_t OFF_BAR = 21 * MiB;
constexpr size_t ARENA = 22 * MiB;
constexpr size_t OFF_WFNIN = ARENA + 0;
constexpr size_t OFF_WFNOUT = ARENA + 8 * MiB;
constexpr size_t OFF_WG = 252 * MiB;
constexpr size_t OFF_A0 = ARENA + 14 * MiB;
constexpr size_t OFF_YTL = ARENA + 31 * MiB;
constexpr size_t OFF_YTC = ARENA + 63 * MiB;
constexpr size_t OFF_SZ0 = ARENA + 64 * MiB;
constexpr size_t OFF_ZT = ARENA + 97 * MiB;
constexpr size_t OFF_VT = ARENA + 161 * MiB;
constexpr size_t OFF_QN = ARENA + 0;
constexpr size_t OFF_SZ1 = ARENA + 17 * MiB;
constexpr size_t OFF_REC = ARENA + 50 * MiB;
constexpr size_t OFF_KNT = ARENA + 116 * MiB;
constexpr size_t OFF_VTT = ARENA + 133 * MiB;
constexpr size_t OFF_O0 = ARENA + 166 * MiB;
constexpr size_t OFF_O1 = ARENA + 198 * MiB;
constexpr size_t OFF_KN = ARENA + 198 * MiB;
constexpr size_t WS_NEED = 254 * MiB;
constexpr int REC_BYTES = 31744;
constexpr int NSTEP = 132;
constexpr int LDS_BYTES = 78848;

struct Params {
  const float *x, *c, *ctx, *c_ctx, *mod_w, *mod_b, *norm_g, *final_g, *fn_w_in, *fn_w_grp, *fn_w_out,
      *dn_w_in, *dn_conv, *dn_a_log, *dn_dt_bias, *dn_norm_g, *dn_w_out;
  float* out;
  char* ws;
  int ph_lo, ph_hi;
};

DI int tidx() {
  int t = threadIdx.x;
  asm volatile("" : "+v"(t));
  return t;
}
DI float silu_f(float v) { return v / (1.f + __expf(-v)); }
DI f16v mfma16(h8 a, h8 b, f16v c) { return __builtin_amdgcn_mfma_f32_32x32x16_f16(a, b, c, 0, 0, 0); }
DI uint4 ldg4(const void* p) { return *(const uint4*)p; }
DI int rowmap(int r, int hh) { return 8 * (r >> 2) + 4 * hh + (r & 3); }
DI h8 cvt8(const f16v& a, int s) {
  h8 r;
#pragma unroll
  for (int j = 0; j < 8; ++j) r[j] = (hf)a[8 * s + j];
  return r;
}

constexpr int LDP = 40;
template <bool SWAP, class AF, class BF>
DI void gemm_main(hf* lds, int K, AF arow, BF brow, f16v (&acc)[2][2]) {
  const int tid = tidx(), lane = tid & 63, wid = tid >> 6;
  const int wr = wid >> 1, wc = wid & 1;
  hf* sA = lds;
  hf* sB = lds + 2 * 128 * LDP;
  const int lr = tid >> 2, kc = (tid & 3) * 8;
  const hf* pa0 = arow(lr) + kc;
  const hf* pa1 = arow(lr + 64) + kc;
  const hf* pb0 = brow(lr) + kc;
  const hf* pb1 = brow(lr + 64) + kc;
#pragma unroll
  for (int i = 0; i < 2; ++i)
#pragma unroll
    for (int j = 0; j < 2; ++j)
#pragma unroll
      for (int r = 0; r < 16; ++r) acc[i][j][r] = 0.f;
  uint4 ra0 = ldg4(pa0), ra1 = ldg4(pa1), rb0 = ldg4(pb0), rb1 = ldg4(pb1);
  const int wo0 = lr * LDP + kc, wo1 = (lr + 64) * LDP + kc;
  *(uint4*)(sA + wo0) = ra0;
  *(uint4*)(sA + wo1) = ra1;
  *(uint4*)(sB + wo0) = rb0;
  *(uint4*)(sB + wo1) = rb1;
  __syncthreads();
  const int nk = K >> 5;
  const int aoff = (wr * 64 + (lane & 31)) * LDP + (lane >> 5) * 8;
  const int boff = (wc * 64 + (lane & 31)) * LDP + (lane >> 5) * 8;
  for (int kt = 0; kt < nk; ++kt) {
    const int cur = kt & 1;
    const bool more = (kt + 1 < nk);
    if (more) {
      const int ko = (kt + 1) * 32;
      ra0 = ldg4(pa0 + ko);
      ra1 = ldg4(pa1 + ko);
      rb0 = ldg4(pb0 + ko);
      rb1 = ldg4(pb1 + ko);
    }
    const hf* cA = sA + cur * 128 * LDP;
    const hf* cB = sB + cur * 128 * LDP;
#pragma unroll
    for (int ks = 0; ks < 2; ++ks) {
      h8 a0 = *(const h8*)(cA + aoff + ks * 16), a1 = *(const h8*)(cA + aoff + 32 * LDP + ks * 16);
      h8 b0 = *(const h8*)(cB + boff + ks * 16), b1 = *(const h8*)(cB + boff + 32 * LDP + ks * 16);
      if (SWAP) {
        acc[0][0] = mfma16(b0, a0, acc[0][0]);
        acc[0][1] = mfma16(b1, a0, acc[0][1]);
        acc[1][0] = mfma16(b0, a1, acc[1][0]);
        acc[1][1] = mfma16(b1, a1, acc[1][1]);
      } else {
        acc[0][0] = mfma16(a0, b0, acc[0][0]);
        acc[0][1] = mfma16(a0, b1, acc[0][1]);
        acc[1][0] = mfma16(a1, b0, acc[1][0]);
        acc[1][1] = mfma16(a1, b1, acc[1][1]);
      }
    }
    if (more) {
      hf* nA = sA + (cur ^ 1) * 128 * LDP;
      hf* nB = sB + (cur ^ 1) * 128 * LDP;
      *(uint4*)(nA + wo0) = ra0;
      *(uint4*)(nA + wo1) = ra1;
      *(uint4*)(nB + wo0) = rb0;
      *(uint4*)(nB + wo1) = rb1;
    }
    __syncthreads();
  }
}
template <bool SWAP, class AF, class BF>
DI void gemm_main2(hf* lds, int K, AF arow, BF brow, f16v (&acc)[2][2]) {
  const int tid = tidx(), lane = tid & 63, wid = tid >> 6;
  const int wr = wid >> 1, wc = wid & 1;
  char* ldsb = (char*)lds;
  const int rsub = lane >> 2, cp = lane & 3;
  const int r0 = (wid * 2) * 16 + rsub, r1 = (wid * 2 + 1) * 16 + rsub;
  const int cl0 = (cp ^ ((r0 >> 2) & 3)) * 8, cl1 = (cp ^ ((r1 >> 2) & 3)) * 8;
  const hf* pa0 = arow(r0) + cl0;
  const hf* pa1 = arow(r1) + cl1;
  const hf* pb0 = brow(r0) + cl0;
  const hf* pb1 = brow(r1) + cl1;
  const int dA0 = __builtin_amdgcn_readfirstlane(wid) * 2048, dA1 = dA0 + 1024;
#pragma unroll
  for (int i = 0; i < 2; ++i)
#pragma unroll
    for (int j = 0; j < 2; ++j)
#pragma unroll
      for (int r = 0; r < 16; ++r) acc[i][j][r] = 0.f;
  auto issue = [&](int kt) {
    char* st = ldsb + (kt & 3) * 16384;
    const int ko = kt * 32;
    __builtin_amdgcn_global_load_lds((const unsigned*)(pa0 + ko), (unsigned*)(st + dA0), 16, 0, 0);
    __builtin_amdgcn_global_load_lds((const unsigned*)(pa1 + ko), (unsigned*)(st + dA1), 16, 0, 0);
    __builtin_amdgcn_global_load_lds((const unsigned*)(pb0 + ko), (unsigned*)(st + 8192 + dA0), 16, 0, 0);
    __builtin_amdgcn_global_load_lds((const unsigned*)(pb1 + ko), (unsigned*)(st + 8192 + dA1), 16, 0, 0);
  };
  const int nk = K >> 5;
  issue(0);
  issue(1);
  issue(2);
  const int l31 = lane & 31, hh = lane >> 5, swz = (l31 >> 2) & 3;
  const int fo0 = ((0 + hh) ^ swz) * 16, fo1 = ((2 + hh) ^ swz) * 16;
  const int arb = (wr * 64 + l31) * 64, brb = 8192 + (wc * 64 + l31) * 64;
  for (int kt = 0; kt < nk; ++kt) {
    if (kt + 2 < nk) asm volatile("s_waitcnt vmcnt(8) lgkmcnt(0)" ::: "memory");
    else if (kt + 1 < nk) asm volatile("s_waitcnt vmcnt(4) lgkmcnt(0)" ::: "memory");
    else asm volatile("s_waitcnt vmcnt(0)" ::: "memory");
    __builtin_amdgcn_s_barrier();
    const char* st = ldsb + (kt & 3) * 16384;
#pragma unroll
    for (int ks = 0; ks < 2; ++ks) {
      const int fo = ks ? fo1 : fo0;
      if (ks == 1 && kt + 3 < nk) issue(kt + 3);
      h8 a0 = *(const h8*)(st + arb + fo), a1 = *(const h8*)(st + arb + 2048 + fo);
      h8 b0 = *(const h8*)(st + brb + fo), b1 = *(const h8*)(st + brb + 2048 + fo);
      if (SWAP) {
        acc[0][0] = mfma16(b0, a0, acc[0][0]);
        acc[0][1] = mfma16(b1, a0, acc[0][1]);
        acc[1][0] = mfma16(b0, a1, acc[1][0]);
        acc[1][1] = mfma16(b1, a1, acc[1][1]);
      } else {
        acc[0][0] = mfma16(a0, b0, acc[0][0]);
        acc[0][1] = mfma16(a0, b1, acc[0][1]);
        acc[1][0] = mfma16(a1, b0, acc[1][0]);
        acc[1][1] = mfma16(a1, b1, acc[1][1]);
      }
    }
  }
  __builtin_amdgcn_s_barrier();
}
template <bool SWAP, class F>
DI void gemm_epi(f16v (&acc)[2][2], F f) {
  const int tid = tidx(), lane = tid & 63, wid = tid >> 6;
  const int wr = wid >> 1, wc = wid & 1, hh = lane >> 5, l31 = lane & 31;
#pragma unroll
  for (int i = 0; i < 2; ++i)
#pragma unroll
    for (int j = 0; j < 2; ++j)
#pragma unroll
      for (int q = 0; q < 4; ++q) {
        if (SWAP) {
          int m = wr * 64 + i * 32 + l31, n0 = wc * 64 + j * 32 + 8 * q + 4 * hh;
          f(m, n0, acc[i][j][4 * q], acc[i][j][4 * q + 1], acc[i][j][4 * q + 2], acc[i][j][4 * q + 3]);
        } else {
          int m0 = wr * 64 + i * 32 + 8 * q + 4 * hh, n = wc * 64 + j * 32 + l31;
          f(m0, n, acc[i][j][4 * q], acc[i][j][4 * q + 1], acc[i][j][4 * q + 2], acc[i][j][4 * q + 3]);
        }
      }
}
DI h4 mk4(float a, float b, float c, float d) {
  h4 r;
  r[0] = (hf)a; r[1] = (hf)b; r[2] = (hf)c; r[3] = (hf)d;
  return r;
}

DI void transpose_tile(const float* src, int K, int N, hf* dst, int tk, int tn, float* lds) {
  const int tid = tidx();
  const int c4 = (tid & 15) * 4, n = tn * 64 + c4;
#pragma unroll
  for (int i = 0; i < 4; ++i) {
    int k = (tid >> 4) + i * 16;
    float4 v = make_float4(0.f, 0.f, 0.f, 0.f);
    if (n < N) v = *(const float4*)(src + (size_t)(tk * 64 + k) * N + n);
    lds[k * 65 + c4 + 0] = v.x;
    lds[k * 65 + c4 + 1] = v.y;
    lds[k * 65 + c4 + 2] = v.z;
    lds[k * 65 + c4 + 3] = v.w;
  }
  __syncthreads();
#pragma unroll
  for (int i = 0; i < 2; ++i) {
    int q = tid + i * 256;
    int nn = q >> 3, k8 = (q & 7) * 8;
    h8 o;
#pragma unroll
    for (int j = 0; j < 8; ++j) o[j] = (hf)lds[(k8 + j) * 65 + nn];
    *(h8*)(dst + (size_t)(tn * 64 + nn) * K + tk * 64 + k8) = o;
  }
  __syncthreads();
}

DI void phase_prep(const Params& p, char* ldsc, int which) {
  const int tid = tidx();
  float* lds = (float*)ldsc;
  size_t wsz_ = 0;
  asm volatile("" : "+s"(wsz_));
  char* ws = p.ws + wsz_;
  constexpr int N1 = 1024, N2 = 512, N3 = 1568, N4 = 512, N5 = 512, N6 = 736, N7 = 384;
  constexpr int TOT = N1 + N2 + N3 + N4 + N5 + N6 + N7;
  for (int it = blockIdx.x; it < TOT; it += gridDim.x) {
    int i = it;
    {
      const bool l0 = (i < N1 + N2);
      if (l0 != (which == 1)) continue;
    }
    if (i < N1) { transpose_tile(p.fn_w_in, 1024, 4096, (hf*)(ws + OFF_WFNIN), i / 64, i % 64, lds); continue; }
    i -= N1;
    if (i < N2) { transpose_tile(p.fn_w_out, 2048, 1024, (hf*)(ws + OFF_WFNOUT), i / 16, i % 16, lds); continue; }
    i -= N2;
    if (i < N3) { transpose_tile(p.dn_w_in, 1024, 6176, (hf*)(ws + OFF_WDNIN), i / 98, i % 98, lds); continue; }
    i -= N3;
    if (i < N4) { transpose_tile(p.dn_w_out, 2048, 1024, (hf*)(ws + OFF_WDNOUT), i / 16, i % 16, lds); continue; }
    i -= N4;
    if (i < N5) {
      const int g = i >> 6, c0 = (i & 63) * 4, d = tid;
      float sv, cv;
      sincospif((float)tid / 128.f, &sv, &cv);
      lds[tid] = cv;
      lds[256 + tid] = sv;
      __syncthreads();
      float ac[4], as[4];
#pragma unroll
      for (int j = 0; j < 4; ++j) { ac[j] = 0.f; as[j] = 0.f; }
      const float* w = p.fn_w_grp + (size_t)g * 65536 + d;
#pragma unroll 4
      for (int m = 0; m < 256; ++m) {
        float wv = w[m * 256];
#pragma unroll
        for (int j = 0; j < 4; ++j) {
          int idx = (m * (c0 + j)) & 255;
          ac[j] += lds[idx] * wv;
          as[j] += lds[256 + idx] * wv;
        }
      }
      hf* dst = (hf*)(ws + OFF_WG) + (size_t)(g * 256 + d) * 512;
      *(h4*)(dst + c0) = mk4(ac[0] * 0.0625f, ac[1] * 0.0625f, ac[2] * 0.0625f, ac[3] * 0.0625f);
      *(h4*)(dst + 256 + c0) = mk4(as[0] * 0.0625f, as[1] * 0.0625f, as[2] * 0.0625f, as[3] * 0.0625f);
      __syncthreads();
      continue;
    }
    i -= N5;
    if (i < N6) {
      int e = i * 256 + tid;
      if (e < 32768) {
        int n = e >> 7, l1 = e & 127;
        int im = (n >> 5) & 1, k1 = (n >> 6) * 32 + (n & 31);
        float sv, cv;
        sincospif((float)((k1 * l1) & 127) / 64.f, &sv, &cv);
        ((hf*)(ws + OFF_TW1))[e] = (hf)((im ? -sv : cv) * 0.08838834764831845f);
      } else if (e < 32768 + 16384) {
        int e2 = e - 32768;
        int n = e2 >> 7, kk = e2 & 127;
        int im = n >> 6, k2 = n & 63, l2 = kk & 63, hi = kk >> 6;
        float sv, cv;
        sincospif((float)((k2 * l2) & 63) / 32.f, &sv, &cv);
        float v = (im == 0) ? (hi ? sv : cv) : (hi ? cv : -sv);
        ((hf*)(ws + OFF_TW2))[e2] = (hf)(v * 0.125f);
      } else if (e < 32768 + 16384 + 131072) {
        int e2 = e - 49152;
        int n = e2 >> 8, l = e2 & 255;
        int im = n >> 8, k = n & 255;
        float sv, cv;
        sincospif((float)((k * l) & 255) / 128.f, &sv, &cv);
        ((hf*)(ws + OFF_T256))[e2] = (hf)((im ? -sv : cv) * 0.0625f);
      } else if (e < 32768 + 16384 + 131072 + 8192) {
        int j = e - 180224;
        float sv, cv;
        sincospif((float)j / 4096.f, &sv, &cv);
        ((float*)(ws + OFF_TWID))[2 * j] = cv;
        ((float*)(ws + OFF_TWID))[2 * j + 1] = sv;
      }
      continue;
    }
    i -= N6;
    {
      const int q0 = i * 16, layer = q0 / 3072, n = (q0 % 3072) + (tid & 15), ks = tid >> 4;
      for (int e = tid; e < 3072; e += 256) {
        int cond = e >> 10, k = e & 1023;
        float v = cond == 0 ? p.c[k] : (cond == 1 ? p.c[1024 + k] : p.c_ctx[k]);
        lds[e] = silu_f(v);
      }
      __syncthreads();
      float a0 = 0.f, a1 = 0.f, a2 = 0.f;
      const float* w = p.mod_w + (size_t)layer * 1024 * 3072 + n;
#pragma unroll 16
      for (int k = ks * 64; k < ks * 64 + 64; ++k) {
        float wv = w[(size_t)k * 3072];
        a0 += lds[k] * wv;
        a1 += lds[1024 + k] * wv;
        a2 += lds[2048 + k] * wv;
      }
      float* red = lds + 3072;
      red[(ks * 3 + 0) * 16 + (tid & 15)] = a0;
      red[(ks * 3 + 1) * 16 + (tid & 15)] = a1;
      red[(ks * 3 + 2) * 16 + (tid & 15)] = a2;
      __syncthreads();
      if (tid < 48) {
        int cond = tid >> 4, cl = tid & 15;
        float sacc = 0.f;
#pragma unroll
        for (int j = 0; j < 16; ++j) sacc += red[(j * 3 + cond) * 16 + cl];
        int nn = (q0 % 3072) + cl;
        ((float*)(ws + OFF_MOD))[(layer * 3 + cond) * 3072 + nn] = sacc + p.mod_b[layer * 3072 + nn];
      }
      __syncthreads();
    }
  }
}

DI void phase_normmod(const Params& p, int b, int layer) {
  const int tid = tidx(), lane = tid & 63, wid = tid >> 6;
  size_t wsz_ = 0;
  asm volatile("" : "+s"(wsz_));
  char* ws = p.ws + wsz_;
  hf* A = (hf*)(ws + (layer == 0 ? OFF_A0 : OFF_QN));
  const float* modb = (const float*)(ws + OFF_MOD);
  const float* g = p.norm_g + layer * 1024;
  for (int it = blockIdx.x; it < ROWS / 4; it += gridDim.x) {
    const int r = it * 4 + wid;
    const float* src;
    int cond;
    if (r < SEQ) {
      src = (layer == 0 ? p.x : p.out) + ((size_t)b * SEQ + r) * D;
      cond = b;
    } else {
      src = (layer == 0) ? p.ctx + ((size_t)b * CTXL + (r - SEQ)) * D : (const float*)(ws + OFF_HCTX) + (size_t)(r - SEQ) * D;
      cond = 2;
    }
    const float* mb = modb + (layer * 3 + cond) * 3072;
    float4 v[4];
    float ss = 0.f;
#pragma unroll
    for (int k = 0; k < 4; ++k) {
      v[k] = *(const float4*)(src + k * 256 + lane * 4);
      ss += v[k].x * v[k].x + v[k].y * v[k].y + v[k].z * v[k].z + v[k].w * v[k].w;
    }
#pragma unroll
    for (int o = 32; o >= 1; o >>= 1) ss += __shfl_xor(ss, o);
    const float rstd = rsqrtf(ss * (1.f / 1024.f) + EPS);
#pragma unroll
    for (int k = 0; k < 4; ++k) {
      int col = k * 256 + lane * 4;
      float4 gg = *(const float4*)(g + col), sh = *(const float4*)(mb + col), sc = *(const float4*)(mb + 1024 + col);
      h4 o = mk4(v[k].x * rstd * gg.x * (1.f + sc.x) + sh.x, v[k].y * rstd * gg.y * (1.f + sc.y) + sh.y,
                 v[k].z * rstd * gg.z * (1.f + sc.z) + sh.z, v[k].w * rstd * gg.w * (1.f + sc.w) + sh.w);
      *(h4*)(A + (size_t)r * D + col) = o;
      if (layer == 0 && r >= SEQ) *(float4*)((float*)(ws + OFF_HCTX) + (size_t)(r - SEQ) * D + col) = v[k];
    }
  }
}

DI void phase_gemm1(const Params& p, hf* lds) {
  size_t wsz_ = 0;
  asm volatile("" : "+s"(wsz_));
  char* ws = p.ws + wsz_;
  const hf* A = (const hf*)(ws + OFF_A0);
  const hf* W = (const hf*)(ws + OFF_WFNIN);
  hf* ytl = (hf*)(ws + OFF_YTL);
  hf* ytc = (hf*)(ws + OFF_YTC);
  hf* sz = (hf*)(ws + OFF_SZ0);
  for (int t = blockIdx.x; t < 66 * 32; t += gridDim.x) {
    const int mt = t >> 5, nt = t & 31;
    auto arow = [&](int r) -> const hf* {
      int row = (mt < 64) ? (r * 64 + mt) : (SEQ + (mt - 64) * 128 + r);
      return A + (size_t)row * D;
    };
    auto brow = [&](int r) -> const hf* { return W + (size_t)(nt * 128 + r) * D; };
    f16v acc[2][2];
    if (nt < 16) {
      gemm_main2<false>(lds, D, arow, brow, acc);
      gemm_epi<false>(acc, [&](int m0, int n, float a, float b, float c, float d) {
        int col = nt * 128 + n;
        h4 o = mk4(a, b, c, d);
        if (mt < 64) *(h4*)(ytl + ((size_t)col * 64 + mt) * 128 + m0) = o;
        else *(h4*)(ytc + (size_t)col * 256 + (mt - 64) * 128 + m0) = o;
      });
    } else {
      gemm_main2<true>(lds, D, arow, brow, acc);
      gemm_epi<true>(acc, [&](int m, int n0, float a, float b, float c, float d) {
        int row = (mt < 64) ? (m * 64 + mt) : (SEQ + (mt - 64) * 128 + m);
        int col = (nt - 16) * 128 + n0;
        *(h4*)(sz + (size_t)row * 2048 + col) = mk4(silu_f(a), silu_f(b), silu_f(c), silu_f(d));
      });
    }
  }
}

DI void phase_stageA(const Params& p, hf* lds) {
  size_t wsz_ = 0;
  asm volatile("" : "+s"(wsz_));
  char* ws = p.ws + wsz_;
  const hf* ytl = (const hf*)(ws + OFF_YTL);
  const hf* ytc = (const hf*)(ws + OFF_YTC);
  const hf* w1 = (const hf*)(ws + OFF_TW1);
  const hf* w256 = (const hf*)(ws + OFF_T256);
  const float2* tw = (const float2*)(ws + OFF_TWID);
  hf* zt = (hf*)(ws + OFF_ZT);
  hf* vt = (hf*)(ws + OFF_VT);
  const int lane = tidx() & 63, wid = tidx() >> 6, wr = wid >> 1, wc = wid & 1, hh = lane >> 5, l31 = lane & 31;
  for (int t = blockIdx.x; t < 2048 + 64; t += gridDim.x) {
    f16v acc[2][2];
    if (t < 2048) {
      const int mt = t >> 1, nt = t & 1;
      auto arow = [&](int r) -> const hf* { return ytl + (size_t)(mt * 128 + r) * 128; };
      auto brow = [&](int r) -> const hf* { return w1 + (size_t)(nt * 128 + r) * 128; };
      gemm_main2<false>(lds, 128, arow, brow, acc);
      const int k1 = (nt * 2 + wc) * 32 + l31;
#pragma unroll
      for (int i = 0; i < 2; ++i)
#pragma unroll
        for (int q = 0; q < 4; ++q) {
          const int m0 = mt * 128 + wr * 64 + i * 32 + 8 * q + 4 * hh;
          const int col = m0 >> 6, l2 = m0 & 63;
          float zr[4], zi[4];
#pragma unroll
          for (int e = 0; e < 4; ++e) {
            float2 cs = tw[(k1 * (l2 + e)) & 8191];
            float re = acc[i][0][4 * q + e], im = acc[i][1][4 * q + e];
            zr[e] = re * cs.x + im * cs.y;
            zi[e] = im * cs.x - re * cs.y;
          }
          size_t base = (((size_t)k1 * 2048 + col) * 2) * 64 + l2;
          *(h4*)(zt + base) = mk4(zr[0], zr[1], zr[2], zr[3]);
          *(h4*)(zt + base + 64) = mk4(zi[0], zi[1], zi[2], zi[3]);
        }
    } else {
      const int tt = t - 2048, mt = tt >> 2, nt = tt & 3;
      auto arow = [&](int r) -> const hf* { return ytc + (size_t)(mt * 128 + r) * 256; };
      auto brow = [&](int r) -> const hf* { return w256 + (size_t)(nt * 128 + r) * 256; };
      gemm_main2<false>(lds, 256, arow, brow, acc);
      gemm_epi<false>(acc, [&](int m0, int n, float a, float b, float c, float d) {
        int col = mt * 128 + m0, nn = nt * 128 + n;
        int im = nn >> 8, k = nn & 255, g = col >> 8, cc = col & 255;
        *(h4*)(vt + (size_t)(SEQ + k) * 4096 + g * 512 + im * 256 + cc) = mk4(a, b, c, d);
      });
    }
  }
}

DI void phase_stageB(const Params& p, hf* lds) {
  size_t wsz_ = 0;
  asm volatile("" : "+s"(wsz_));
  char* ws = p.ws + wsz_;
  const hf* zt = (const hf*)(ws + OFF_ZT);
  const hf* w2 = (const hf*)(ws + OFF_TW2);
  hf* vt = (hf*)(ws + OFF_VT);
  for (int t = blockIdx.x; t < 2048; t += gridDim.x) {
    f16v acc[2][2];
    auto arow = [&](int r) -> const hf* { return zt + (size_t)(t * 128 + r) * 128; };
    auto brow = [&](int r) -> const hf* { return w2 + (size_t)r * 128; };
    gemm_main2<false>(lds, 128, arow, brow, acc);
    gemm_epi<false>(acc, [&](int m0, int n, float a, float b, float c, float d) {
      int m = t * 128 + m0;
      int k1 = m >> 11, col = m & 2047, im = n >> 6, k2 = n & 63;
      int g = col >> 8, cc = col & 255;
      *(h4*)(vt + (size_t)(k1 + 128 * k2) * 4096 + g * 512 + im * 256 + cc) = mk4(a, b, c, d);
    });
  }
}

DI void phase_group(const Params& p, hf* lds) {
  size_t wsz_ = 0;
  asm volatile("" : "+s"(wsz_));
  char* ws = p.ws + wsz_;
  const hf* vt = (const hf*)(ws + OFF_VT);
  const hf* wg = (const hf*)(ws + OFF_WG);
  hf* sz = (hf*)(ws + OFF_SZ0);
  for (int t = blockIdx.x; t < 66 * 16; t += gridDim.x) {
    const int mt = t >> 4, g = (t >> 1) & 7, nt = t & 1;
    f16v acc[2][2];
    auto arow = [&](int r) -> const hf* { return vt + (size_t)(mt * 128 + r) * 4096 + g * 512; };
    auto brow = [&](int r) -> const hf* { return wg + (size_t)(g * 256 + nt * 128 + r) * 512; };
    gemm_main2<true>(lds, 512, arow, brow, acc);
    gemm_epi<true>(acc, [&](int m, int n0, float a, float b, float c, float d) {
      hf* q = sz + (size_t)(mt * 128 + m) * 2048 + g * 256 + nt * 128 + n0;
      h4 s = *(const h4*)q;
      *(h4*)q = mk4(a * (float)s[0], b * (float)s[1], c * (float)s[2], d * (float)s[3]);
    });
  }
}

DI void phase_outproj(const Params& p, int b, int layer, hf* lds) {
  size_t wsz_ = 0;
  asm volatile("" : "+s"(wsz_));
  char* ws = p.ws + wsz_;
  const hf* A = (const hf*)(ws + (layer == 0 ? OFF_SZ0 : OFF_SZ1));
  const hf* W = (const hf*)(ws + (layer == 0 ? OFF_WFNOUT : OFF_WDNOUT));
  const float* modb = (const float*)(ws + OFF_MOD);
  const int ntile = layer == 0 ? 512 + 128 : 512;
  for (int t = blockIdx.x; t < ntile; t += gridDim.x) {
    f16v acc[2][2];
    if (t < 512) {
      const int mt = t >> 3, nt = t & 7;
      auto arow = [&](int r) -> const hf* { return A + (size_t)(mt * 128 + r) * 2048; };
      auto brow = [&](int r) -> const hf* { return W + (size_t)(nt * 128 + r) * 2048; };
      gemm_main2<true>(lds, 2048, arow, brow, acc);
      gemm_epi<true>(acc, [&](int m, int n0, float a0, float a1, float a2, float a3) {
        int row = mt * 128 + m, col = nt * 128 + n0;
        float* dst = p.out + ((size_t)b * SEQ + row) * D + col;
        const float* src = (layer == 0) ? p.x + ((size_t)b * SEQ + row) * D + col : dst;
        float4 gt = *(const float4*)(modb + (layer * 3 + b) * 3072 + 2048 + col);
        float4 s = *(const float4*)src;
        *(float4*)dst = make_float4(s.x + gt.x * a0, s.y + gt.y * a1, s.z + gt.z * a2, s.w + gt.w * a3);
      });
    } else {
      const int it = t - 512, tile = it >> 3, ksp = it & 7;
      const int mt = 64 + (tile >> 3), nt = tile & 7;
      auto arow = [&](int r) -> const hf* { return A + (size_t)(mt * 128 + r) * 2048 + ksp * 256; };
      auto brow = [&](int r) -> const hf* { return W + (size_t)(nt * 128 + r) * 2048 + ksp * 256; };
      gemm_main2<true>(lds, 256, arow, brow, acc);
      gemm_epi<true>(acc, [&](int m, int n0, float a0, float a1, float a2, float a3) {
        int row = mt * 128 + m - SEQ, col = nt * 128 + n0;
        float* dst = (float*)(ws + OFF_HCTX) + (size_t)row * D + col;
        float4 gt = *(const float4*)(modb + (0 * 3 + 2) * 3072 + 2048 + col);
        unsafeAtomicAdd(dst + 0, gt.x * a0);
        unsafeAtomicAdd(dst + 1, gt.y * a1);
        unsafeAtomicAdd(dst + 2, gt.z * a2);
        unsafeAtomicAdd(dst + 3, gt.w * a3);
      });
    }
  }
}

DI void phase_inproj1(const Params& p, hf* lds) {
  size_t wsz_ = 0;
  asm volatile("" : "+s"(wsz_));
  char* ws = p.ws + wsz_;
  const hf* A = (const hf*)(ws + OFF_QN);
  const hf* W = (const hf*)(ws + OFF_WDNIN);
  hf* pre = (hf*)(ws + OFF_REC);
  hf* sz = (hf*)(ws + OFF_SZ1);
  float* ab = (float*)(ws + OFF_AB);
  for (int t = blockIdx.x; t < 66 * 49; t += gridDim.x) {
    const int mt = t / 49, nt = t % 49;
    f16v acc[2][2];
    auto arow = [&](int r) -> const hf* { return A + (size_t)(mt * 128 + r) * D; };
    auto brow = [&](int r) -> const hf* { return W + (size_t)(nt * 128 + r) * D; };
    gemm_main2<true>(lds, D, arow, brow, acc);
    gemm_epi<true>(acc, [&](int m, int n0, float a, float b, float c, float d) {
      int row = mt * 128 + m, col = nt * 128 + n0;
      if (nt < 32) *(h4*)(pre + (size_t)row * 4096 + col) = mk4(a, b, c, d);
      else if (nt < 48) *(h4*)(sz + (size_t)row * 2048 + (col - 4096)) = mk4(silu_f(a), silu_f(b), silu_f(c), silu_f(d));
      else if (col - 6144 < 32) *(float4*)(ab + (size_t)row * 32 + (col - 6144)) = make_float4(a, b, c, d);
    });
  }
}

DI void phase_conv(const Params& p, char* ldsc) {
  size_t wsz_ = 0;
  asm volatile("" : "+s"(wsz_));
  char* ws = p.ws + wsz_;
  const int tid = tidx();
  const hf* pre = (const hf*)(ws + OFF_REC);
  hf* tile = (hf*)ldsc;
  const int ch8 = tid & 15, tk = tid >> 4;
  for (int it = blockIdx.x; it < 132 * 32; it += gridDim.x) {
    const int rr = it >> 5, cb = it & 31;
    const bool isctx = rr >= 128;
    const int T = isctx ? CTXL : SEQ;
    const int t0 = isctx ? (rr - 128) * 64 : rr * 64;
    int chbase, kind, head, dvo = 0;
    if (cb < 8) { kind = 0; head = cb; chbase = cb * 128; }
    else if (cb < 16) { kind = 1; head = cb - 8; chbase = 1024 + (cb - 8) * 128; }
    else { kind = 2; head = (cb - 16) >> 1; dvo = ((cb - 16) & 1) * 128; chbase = 2048 + (cb - 16) * 128; }
    const int ch = chbase + ch8 * 8;
    float w[9][8];
#pragma unroll
    for (int k = 0; k < 9; ++k) {
      float4 wa = *(const float4*)(p.dn_conv + k * 4096 + ch), wb = *(const float4*)(p.dn_conv + k * 4096 + ch + 4);
      w[k][0] = wa.x; w[k][1] = wa.y; w[k][2] = wa.z; w[k][3] = wa.w;
      w[k][4] = wb.x; w[k][5] = wb.y; w[k][6] = wb.z; w[k][7] = wb.w;
    }
    auto ldw = [&](int di, int col) -> h8 {
      int row;
      bool ok;
      if (!isctx) {
        int r2 = rr + di - 1;
        ok = (r2 >= 0) && (r2 < 128) && (col >= 0) && (col < 64);
        row = r2 * 64 + col;
      } else {
        int p2 = t0 + col;
        ok = (di == 1) && (p2 >= 0) && (p2 < 256);
        row = SEQ + p2;
      }
      h8 v;
#pragma unroll
      for (int e = 0; e < 8; ++e) v[e] = (hf)0.f;
      if (ok) v = *(const h8*)(pre + (size_t)row * 4096 + ch);
      return v;
    };
    const int c0 = tk * 4;
    h8 win[3][6];
#pragma unroll
    for (int di = 0; di < 3; ++di)
#pragma unroll
      for (int cx = 0; cx < 6; ++cx) win[di][cx] = ldw(di, c0 - 1 + cx);
#pragma unroll
    for (int pp = 0; pp < 4; ++pp) {
      const int cc = c0 + pp;
      float y[8];
#pragma unroll
      for (int e = 0; e < 8; ++e) y[e] = 0.f;
#pragma unroll
      for (int di = 0; di < 3; ++di) {
#pragma unroll
        for (int e = 0; e < 8; ++e)
          y[e] += (float)win[di][pp][e] * w[di * 3 + 0][e] + (float)win[di][pp + 1][e] * w[di * 3 + 1][e] + (float)win[di][pp + 2][e] * w[di * 3 + 2][e];
      }
      float ss = 0.f;
#pragma unroll
      for (int e = 0; e < 8; ++e) { y[e] = silu_f(y[e]); ss += y[e] * y[e]; }
      if (kind < 2) {
        ss += __shfl_xor(ss, 1);
        ss += __shfl_xor(ss, 2);
        ss += __shfl_xor(ss, 4);
        ss += __shfl_xor(ss, 8);
        float sc = rsqrtf(ss + EPS) * (kind == 0 ? 0.08838834764831845f : 1.f);
#pragma unroll
        for (int e = 0; e < 8; ++e) y[e] *= sc;
      }
      h8 o;
#pragma unroll
      for (int e = 0; e < 8; ++e) o[e] = (hf)y[e];
      if (kind < 2) {
        hf* base = (hf*)(ws + (kind == 0 ? OFF_QN : OFF_KN)) + (isctx ? (size_t)8 * SEQ * 128 : 0);
        *(h8*)(base + ((size_t)head * T + t0 + cc) * 128 + ch8 * 8) = o;
      }
      if (kind >= 1) {
#pragma unroll
        for (int e = 0; e < 8; ++e) tile[(ch8 * 8 + e) * 72 + cc] = o[e];
      }
    }
    if (kind >= 1) {
      __syncthreads();
      const int chunk = rr;
      hf* base;
      if (kind == 1) base = (hf*)(ws + OFF_KNT) + ((size_t)(head * 132 + chunk) * 128) * 64;
      else base = (hf*)(ws + OFF_VTT) + ((size_t)(head * 132 + chunk) * 256 + dvo) * 64;
#pragma unroll
      for (int k = 0; k < 4; ++k) {
        int q = tid + 256 * k;
        int c = q >> 3, t8 = q & 7;
        h8 v = *(const h8*)(tile + c * 72 + t8 * 8);
        *(h8*)(base + (size_t)c * 64 + t8 * 8) = v;
      }
      __syncthreads();
    }
  }
}

DI void step_geom(int s, int d, bool& isctx, int& T, int& t0) {
  isctx = s < 4;
  int oc = isctx ? (d ? 3 - s : s) : (d ? 127 - (s - 4) : (s - 4));
  T = isctx ? CTXL : SEQ;
  t0 = oc * 64;
}
DI int step_chunk(int s, int d) {
  return (s < 4) ? 128 + (d ? 3 - s : s) : (d ? 127 - (s - 4) : (s - 4));
}

DI void phase_dprep(const Params& p, char* ldsc) {
  size_t wsz_ = 0;
  asm volatile("" : "+s"(wsz_));
  char* ws = p.ws + wsz_;
  const int tid = tidx(), lane = tid & 63, wid = tid >> 6, hh = lane >> 5, l31 = lane & 31;
  hf* kS = (hf*)ldsc;
  hf* qS = kS + 64 * 136;
  float* Ns = (float*)(qS + 64 * 136);
  hf* Tbs = (hf*)(Ns + 64 * 68);
  hf* Tws = Tbs + 64 * 72;
  float* gcs = (float*)(Tws + 64 * 72);
  float* bts = gcs + 64;
  const float* ab = (const float*)(ws + OFF_AB);
  for (int it = blockIdx.x; it < 8 * 2 * NSTEP; it += gridDim.x) {
    const int h = it / (2 * NSTEP), d = (it / NSTEP) & 1, s = it % NSTEP;
    bool isctx; int T, t0;
    step_geom(s, d, isctx, T, t0);
    const int row0 = isctx ? SEQ + t0 : t0;
    char* rec = ws + OFF_REC + (size_t)it * REC_BYTES;
    const hf* qn = (const hf*)(ws + OFF_QN) + (isctx ? (size_t)8 * SEQ * 128 : 0) + ((size_t)h * T + t0) * 128;
    const hf* kn = (const hf*)(ws + OFF_KN) + (isctx ? (size_t)8 * SEQ * 128 : 0) + ((size_t)h * T + t0) * 128;
    const hf* knt = (const hf*)(ws + OFF_KNT) + ((size_t)(h * 132 + step_chunk(s, d)) * 128) * 64;
    if (tid < 64) {
      const int pp = tid;
      float a = ab[(size_t)(row0 + pp) * 32 + d * 8 + h], bb = ab[(size_t)(row0 + pp) * 32 + 16 + d * 8 + h];
      float xx = a + p.dn_dt_bias[d * 8 + h];
      float sp = fmaxf(xx, 0.f) + log1pf(expf(-fabsf(xx)));
      float g = -expf(p.dn_a_log[d * 8 + h]) * sp;
      float beta = 1.f / (1.f + expf(-bb));
      float v = g;
#pragma unroll
      for (int o = 1; o < 64; o <<= 1) {
        float nb = d ? __shfl_down(v, o) : __shfl_up(v, o);
        bool ok = d ? (pp + o < 64) : (pp >= o);
        if (ok) v += nb;
      }
      gcs[pp] = v;
      bts[pp] = beta;
    }
#pragma unroll
    for (int k = 0; k < 4; ++k) {
      int q = tid + 256 * k;
      int r = q >> 4, c16 = q & 15;
      *(uint4*)(kS + r * 136 + c16 * 8) = ldg4(kn + (size_t)r * 128 + c16 * 8);
      *(uint4*)(qS + r * 136 + c16 * 8) = ldg4(qn + (size_t)r * 128 + c16 * 8);
    }
    __syncthreads();
    const float glast = d ? gcs[0] : gcs[63];
    {
      const int ta = wid >> 1, tb = wid & 1;
      f16v akk, aqk;
#pragma unroll
      for (int r = 0; r < 16; ++r) { akk[r] = 0.f; aqk[r] = 0.f; }
#pragma unroll
      for (int ks = 0; ks < 8; ++ks) {
        h8 fa = *(const h8*)(kS + (ta * 32 + l31) * 136 + ks * 16 + hh * 8);
        h8 fb = *(const h8*)(kS + (tb * 32 + l31) * 136 + ks * 16 + hh * 8);
        h8 fq = *(const h8*)(qS + (tb * 32 + l31) * 136 + ks * 16 + hh * 8);
        akk = mfma16(fa, fb, akk);
        aqk = mfma16(fa, fq, aqk);
      }
      const int pb = tb * 32 + l31;
      const float gb = gcs[pb];
      h8 f0, f1;
#pragma unroll
      for (int r = 0; r < 16; ++r) {
        const int pa = ta * 32 + rowmap(r, hh);
        const float ga = gcs[pa];
        bool strict = d ? (pb > pa) : (pb < pa);
        if (strict) {
          int i = d ? 63 - pa : pa, j = d ? 63 - pb : pb;
          Ns[i * 68 + j] = bts[pa] * akk[r] * __expf(ga - gb);
        }
        bool le = d ? (pa >= pb) : (pa <= pb);
        float v = le ? aqk[r] * __expf(gb - ga) : 0.f;
        if (r < 8) f0[r] = (hf)v; else f1[r - 8] = (hf)v;
      }
      if (!isctx) {
        int slot = (ta == tb) ? ta : ((d ? (ta > tb) : (ta < tb)) ? 2 : -1);
        if (slot >= 0) {
          hf* dst = (hf*)(rec + 16384 + 8192);
          *(h8*)(dst + ((slot * 2 + 0) * 64 + lane) * 8) = f0;
          *(h8*)(dst + ((slot * 2 + 1) * 64 + lane) * 8) = f1;
        }
      }
    }
    __syncthreads();
    float* Tf = (float*)kS;
    float* Xf = Tf + 64 * 68;
    if (wid < 2) {
      const int base = wid * 32, cl = lane & 31;
      int zofs = 0;
      asm volatile("" : "+v"(zofs));
      const float* Nz = Ns + zofs + base * 68 + base;
      float nrow[32];
#pragma unroll
      for (int i = 1; i < 32; ++i) nrow[i] = Nz[i * 68 + cl];
      float tt[32];
#pragma unroll
      for (int i = 0; i < 32; ++i) {
        float a = (i == cl) ? 1.f : 0.f;
        float nr = (i > 0) ? nrow[i] : 0.f;
        if (i > 0) asm volatile("" : "+v"(nr) : "v"(tt[i - 1]));
#pragma unroll
        for (int j = 0; j < i; ++j)
          a -= __builtin_bit_cast(float, __builtin_amdgcn_readlane(__builtin_bit_cast(int, nr), j)) * tt[j];
        tt[i] = a;
      }
      if (lane < 32) {
#pragma unroll
        for (int i = 0; i < 32; ++i) Tf[(base + i) * 68 + base + cl] = tt[i];
      }
    } else if (wid == 2) {
      float* vec = (float*)(rec + 16384 + 8192 + 6144);
      vec[lane] = __expf(gcs[lane]);
      vec[64 + lane] = __expf(glast - gcs[lane]);
      if (lane == 0) vec[128] = __expf(glast);
    }
    __syncthreads();
    {
      const int i = tid >> 3, c4 = (tid & 7) * 4;
      float x0 = 0.f, x1 = 0.f, x2 = 0.f, x3 = 0.f;
#pragma unroll 8
      for (int j = 0; j < 32; ++j) {
        const float n = Ns[(32 + i) * 68 + j];
        const float4 t = *(const float4*)(Tf + j * 68 + c4);
        x0 += n * t.x; x1 += n * t.y; x2 += n * t.z; x3 += n * t.w;
      }
      *(float4*)(Xf + i * 36 + c4) = make_float4(x0, x1, x2, x3);
    }
    __syncthreads();
    {
      const int i = tid >> 3, c4 = (tid & 7) * 4;
      float y0 = 0.f, y1 = 0.f, y2 = 0.f, y3 = 0.f;
#pragma unroll 8
      for (int k = 0; k < 32; ++k) {
        const float t = (k <= i) ? Tf[(32 + i) * 68 + 32 + k] : 0.f;
        const float4 x = *(const float4*)(Xf + k * 36 + c4);
        y0 += t * x.x; y1 += t * x.y; y2 += t * x.z; y3 += t * x.w;
      }
      *(float4*)(Tf + (32 + i) * 68 + c4) = make_float4(-y0, -y1, -y2, -y3);
      *(float4*)(Tf + i * 68 + 32 + c4) = make_float4(0.f, 0.f, 0.f, 0.f);
    }
    __syncthreads();
    {
      const int i = tid >> 2, c0 = (tid & 3) * 16;
      const int pi = d ? 63 - i : i;
#pragma unroll
      for (int e = 0; e < 16; ++e) {
        const int c = c0 + e, pc = d ? 63 - c : c;
        const float v = Tf[i * 68 + c] * bts[pc];
        Tbs[pi * 72 + pc] = (hf)v;
        Tws[pi * 72 + pc] = (hf)(v * __expf(gcs[pc]));
      }
    }
    __syncthreads();
#pragma unroll
    for (int k = 0; k < 2; ++k) {
      int q = tid + 256 * k;
      int r = q >> 3, c8 = q & 7;
      *(uint4*)(rec + 16384 + (size_t)(r * 64 + c8 * 8) * 2) = *(const uint4*)(Tbs + r * 72 + c8 * 8);
    }
    {
      const int dt = wid;
      h8 fa[4];
#pragma unroll
      for (int su = 0; su < 4; ++su) fa[su] = *(const h8*)(knt + (size_t)(dt * 32 + l31) * 64 + su * 16 + hh * 8);
#pragma unroll
      for (int jt = 0; jt < 2; ++jt) {
        f16v a;
#pragma unroll
        for (int r = 0; r < 16; ++r) a[r] = 0.f;
#pragma unroll
        for (int su = 0; su < 4; ++su) {
          h8 fb = *(const h8*)(Tws + (jt * 32 + l31) * 72 + su * 16 + hh * 8);
          a = mfma16(fa[su], fb, a);
        }
        h8 f0, f1;
#pragma unroll
        for (int r = 0; r < 8; ++r) { f0[r] = (hf)(-a[r]); f1[r] = (hf)(-a[8 + r]); }
        hf* dst = (hf*)rec;
        *(h8*)(dst + (((dt * 2 + jt) * 2 + 0) * 64 + lane) * 8) = f0;
        *(h8*)(dst + (((dt * 2 + jt) * 2 + 1) * 64 + lane) * 8) = f1;
      }
    }
    __syncthreads();
  }
}

DI void phase_scan(const Params& p, char* ldsc) {
  size_t wsz_ = 0;
  asm volatile("" : "+s"(wsz_));
  char* ws = p.ws + wsz_;
  const int tid = tidx(), lane = tid & 63, wid = tid >> 6, hh = lane >> 5, l31 = lane & 31;
  const int rw = wid & 1;
  const bool roleB = wid >= 2;
  hf* wS = (hf*)ldsc;
  hf* TbS = wS + 8192;
  hf* qS = TbS + 64 * 64;
  hf* ktS = qS + 64 * 128;
  hf* qkS = ktS + 128 * 64;
  float* vecS = (float*)(qkS + 3072);
  hf* VfS = (hf*)(vecS + 256);
  hf* SfS = VfS + 4 * 64 * 8;
  for (int it = blockIdx.x; it < 128; it += gridDim.x) {
    const int h = it >> 4, d = (it >> 3) & 1, dv8 = it & 7;
    const int dv = dv8 * 32 + l31;
    const char* recb = ws + OFF_REC + (size_t)((h * 2 + d) * NSTEP) * REC_BYTES;
    hf* O = (hf*)(ws + (d ? OFF_O1 : OFF_O0));
    f16v Sd[2];
#pragma unroll
    for (int t = 0; t < 2; ++t)
#pragma unroll
      for (int r = 0; r < 16; ++r) Sd[t][r] = 0.f;
    {
      h8 z;
#pragma unroll
      for (int j = 0; j < 8; ++j) z[j] = (hf)0.f;
      *(h8*)(SfS + ((wid * 2 + 0) * 64 + lane) * 8) = z;
      *(h8*)(SfS + ((wid * 2 + 1) * 64 + lane) * 8) = z;
    }
    h8 vt[4];
    const int wid_s = __builtin_amdgcn_readfirstlane(wid);
    auto dma = [&](const void* src, char* dstbase, int L) {
      __builtin_amdgcn_global_load_lds((const unsigned*)src, (unsigned*)(dstbase + (size_t)(L - tid + wid_s * 64) * 16), 16, 0, 0);
    };
    const int offT = (tid >> 3) * 128 + (((tid & 7) ^ ((tid >> 4) & 7)) * 16);
    const int offQ = (tid >> 4) * 256 + (((tid & 15) ^ ((tid >> 4) & 15)) * 16);
    auto issueG1 = [&](int s) {
      bool isctx; int T, t0;
      step_geom(s, d, isctx, T, t0);
      const char* rec = recb + (size_t)s * REC_BYTES;
      const char* qn = (const char*)((const hf*)(ws + OFF_QN) + (isctx ? (size_t)8 * SEQ * 128 : 0) + ((size_t)h * T + t0) * 128);
#pragma unroll
      for (int k = 0; k < 4; ++k) dma(rec + tid * 16 + k * 4096, (char*)wS, tid + 256 * k);
#pragma unroll
      for (int k = 0; k < 2; ++k) dma(rec + 16384 + offT + k * 4096, (char*)TbS, tid + 256 * k);
#pragma unroll
      for (int k = 0; k < 4; ++k) dma(qn + offQ + k * 4096, (char*)qS, tid + 256 * k);
    };
    auto issueG2 = [&](int s) {
      const char* rec = recb + (size_t)s * REC_BYTES;
      const char* knt = (const char*)((const hf*)(ws + OFF_KNT) + ((size_t)(h * 132 + step_chunk(s, d)) * 128) * 64);
#pragma unroll
      for (int k = 0; k < 4; ++k) dma(knt + offT + k * 4096, (char*)ktS, tid + 256 * k);
      dma(rec + 24576 + tid * 16, (char*)qkS, tid);
      if (tid < 192) dma(rec + 24576 + (tid + 256) * 16, (char*)qkS, tid + 256);
    };
    auto loadV = [&](int s) {
      const hf* vtt = (const hf*)(ws + OFF_VTT) + ((size_t)(h * 132 + step_chunk(s, d)) * 256 + dv) * 64;
#pragma unroll
      for (int su = 0; su < 4; ++su) vt[su] = *(const h8*)(vtt + su * 16 + hh * 8);
    };
    issueG1(0);
    if (!roleB) loadV(0);
    __syncthreads();
#pragma unroll 1
    for (int s = 0; s < NSTEP; ++s) {
      bool isctx; int T, t0;
      step_geom(s, d, isctx, T, t0);
      issueG2(s);
      h8 vf[4];
      f16v ao;
#pragma unroll
      for (int r = 0; r < 16; ++r) ao[r] = 0.f;
      if (!roleB) {
        auto ldA = [&](int i) -> h8 {
          if (i < 4) return *(const h8*)(TbS + (rw * 32 + l31) * 64 + (((i * 2 + hh) ^ ((l31 >> 1) & 7)) * 8));
          const int dt = (i - 4) >> 1, sp = (i - 4) & 1;
          return *(const h8*)(wS + (((dt * 2 + rw) * 2 + sp) * 64 + lane) * 8);
        };
        h8 c0 = ldA(0);
#pragma unroll
        for (int i = 0; i < 12; ++i) {
          h8 n0;
          if (i + 1 < 12) n0 = ldA(i + 1);
          __builtin_amdgcn_sched_barrier(0);
          h8 bf;
          if (i < 4) bf = vt[i];
          else bf = *(const h8*)(SfS + ((i - 4) * 64 + lane) * 8);
          ao = mfma16(c0, bf, ao);
          if (i == 3 && s + 1 < NSTEP) loadV(s + 1);
          __builtin_amdgcn_sched_barrier(0);
          if (i + 1 < 12) c0 = n0;
        }
#pragma unroll
        for (int sp = 0; sp < 2; ++sp) *(h8*)(VfS + ((rw * 2 + sp) * 64 + lane) * 8) = cvt8(ao, sp);
      } else if (!isctx) {
        auto ldQ = [&](int i) -> h8 {
          const hf* qrow = qS + (rw * 32 + l31) * 128 + hh * 4;
          h4 lo = *(const h4*)(qrow + (((2 * i) ^ (l31 & 15)) * 8)), hi = *(const h4*)(qrow + (((2 * i + 1) ^ (l31 & 15)) * 8));
          return __builtin_shufflevector(lo, hi, 0, 1, 2, 3, 4, 5, 6, 7);
        };
        h8 q0 = ldQ(0);
#pragma unroll
        for (int i = 0; i < 8; ++i) {
          h8 n0;
          if (i + 1 < 8) n0 = ldQ(i + 1);
          __builtin_amdgcn_sched_barrier(0);
          ao = mfma16(*(const h8*)(SfS + (i * 64 + lane) * 8), q0, ao);
          __builtin_amdgcn_sched_barrier(0);
          if (i + 1 < 8) q0 = n0;
        }
      }
      if (!roleB && s + 1 < NSTEP) asm volatile("s_waitcnt vmcnt(4) lgkmcnt(0)" ::: "memory");
      else asm volatile("s_waitcnt vmcnt(0) lgkmcnt(0)" ::: "memory");
      __builtin_amdgcn_s_barrier();
      if (s + 1 < NSTEP) issueG1(s + 1);
      __builtin_amdgcn_sched_barrier(0);
#pragma unroll
      for (int f = 0; f < 4; ++f) vf[f] = *(const h8*)(VfS + (f * 64 + lane) * 8);
      if (roleB && !isctx) {
        const float egi = vecS[rw * 32 + l31];
#pragma unroll
        for (int r = 0; r < 16; ++r) ao[r] *= egi;
#pragma unroll
        for (int jt = 0; jt < 2; ++jt) {
          int slot = (jt == rw) ? jt : ((d ? (jt > rw) : (jt < rw)) ? 2 : -1);
          if (slot >= 0) {
#pragma unroll
            for (int sp = 0; sp < 2; ++sp) {
              h8 fk = *(const h8*)(qkS + ((slot * 2 + sp) * 64 + lane) * 8);
              ao = mfma16(vf[jt * 2 + sp], fk, ao);
            }
          }
        }
        hf* dst = O + (size_t)(t0 + rw * 32 + l31) * 2048 + h * 256 + dv8 * 32 + 4 * hh;
#pragma unroll
        for (int q = 0; q < 4; ++q) *(h4*)(dst + 8 * q) = mk4(ao[4 * q], ao[4 * q + 1], ao[4 * q + 2], ao[4 * q + 3]);
      }
      __builtin_amdgcn_sched_barrier(0);
      if (!roleB) {
        const float egl = vecS[128];
        h8 vk[4];
#pragma unroll
        for (int jt = 0; jt < 2; ++jt)
#pragma unroll
          for (int sp = 0; sp < 2; ++sp) {
            h8 f;
#pragma unroll
            for (int j = 0; j < 8; ++j) f[j] = (hf)((float)vf[jt * 2 + sp][j] * vecS[64 + jt * 32 + rowmap(8 * sp + j, hh)]);
            vk[jt * 2 + sp] = f;
          }
        const int ksw = (l31 >> 1) & 7;
#pragma unroll
        for (int t = 0; t < 2; ++t) {
          const int dt = rw * 2 + t;
#pragma unroll
          for (int r = 0; r < 16; ++r) Sd[t][r] *= egl;
          const hf* krow = ktS + (dt * 32 + l31) * 64 + hh * 4;
#pragma unroll
          for (int js = 0; js < 4; ++js) {
            h4 lo = *(const h4*)(krow + (((2 * js) ^ ksw) * 8)), hi = *(const h4*)(krow + (((2 * js + 1) ^ ksw) * 8));
            h8 fk = __builtin_shufflevector(lo, hi, 0, 1, 2, 3, 4, 5, 6, 7);
            Sd[t] = mfma16(fk, vk[js], Sd[t]);
          }
        }
#pragma unroll
        for (int t = 0; t < 2; ++t) {
          const int dt = rw * 2 + t;
          *(h8*)(SfS + ((dt * 2 + 0) * 64 + lane) * 8) = cvt8(Sd[t], 0);
          *(h8*)(SfS + ((dt * 2 + 1) * 64 + lane) * 8) = cvt8(Sd[t], 1);
        }
      }
      __syncthreads();
    }
  }
}

DI void phase_onorm(const Params& p) {
  size_t wsz_ = 0;
  asm volatile("" : "+s"(wsz_));
  char* ws = p.ws + wsz_;
  const int tid = tidx(), lane = tid & 63, wid = tid >> 6;
  const hf* O0 = (const hf*)(ws + OFF_O0);
  const hf* O1 = (const hf*)(ws + OFF_O1);
  hf* sz = (hf*)(ws + OFF_SZ1);
  for (int it = blockIdx.x; it < SEQ / 4; it += gridDim.x) {
    const int row = it * 4 + wid;
#pragma unroll
    for (int k = 0; k < 4; ++k) {
      const int e = k * 512 + lane * 8;
      h8 o = *(const h8*)(O0 + (size_t)row * 2048 + e);
      h8 o1 = *(const h8*)(O1 + (size_t)row * 2048 + e);
      float v[8], ss = 0.f;
#pragma unroll
      for (int j = 0; j < 8; ++j) { v[j] = (float)o[j] + (float)o1[j]; ss += v[j] * v[j]; }
#pragma unroll
      for (int m = 1; m <= 16; m <<= 1) ss += __shfl_xor(ss, m);
      const float rstd = rsqrtf(ss * (1.f / 256.f) + EPS);
      const int dvv = e & 255;
      float4 g0 = *(const float4*)(p.dn_norm_g + dvv), g1 = *(const float4*)(p.dn_norm_g + dvv + 4);
      float gg[8] = {g0.x, g0.y, g0.z, g0.w, g1.x, g1.y, g1.z, g1.w};
      h8 z = *(const h8*)(sz + (size_t)row * 2048 + e);
      h8 r;
#pragma unroll
      for (int j = 0; j < 8; ++j) r[j] = (hf)((float)(hf)(v[j] * rstd * gg[j]) * (float)z[j]);
      *(h8*)(sz + (size_t)row * 2048 + e) = r;
    }
  }
}

DI void phase_final(const Params& p, int b) {
  const int tid = tidx(), lane = tid & 63, wid = tid >> 6;
  for (int it = blockIdx.x; it < SEQ / 4; it += gridDim.x) {
    float* row = p.out + ((size_t)b * SEQ + it * 4 + wid) * D;
    float4 v[4];
    float ss = 0.f;
#pragma unroll
    for (int k = 0; k < 4; ++k) {
      v[k] = *(const float4*)(row + k * 256 + lane * 4);
      ss += v[k].x * v[k].x + v[k].y * v[k].y + v[k].z * v[k].z + v[k].w * v[k].w;
    }
#pragma unroll
    for (int o = 32; o >= 1; o >>= 1) ss += __shfl_xor(ss, o);
    const float rstd = rsqrtf(ss * (1.f / 1024.f) + EPS);
#pragma unroll
    for (int k = 0; k < 4; ++k) {
      float4 g = *(const float4*)(p.final_g + k * 256 + lane * 4);
      *(float4*)(row + k * 256 + lane * 4) = make_float4(v[k].x * rstd * g.x, v[k].y * rstd * g.y, v[k].z * rstd * g.z, v[k].w * rstd * g.w);
    }
  }
}


#define XB_TMO      128
#define XB_XCNT(j)  (256  + 64 * (j))
#define XB_XSUB(j)  (1280 + 64 * (j))
#define XB_XGEN(j)  (2304 + 64 * (j))
#define XB_TOP      3328
#define XB_TOPGEN   3392
#define XCD_BAR_WORDS 3456
#define XB_SPIN_CAP (1u << 18)
#define LAS __attribute__((address_space(3)))
DI unsigned xb_ld(unsigned* p) { return __hip_atomic_load(p, __ATOMIC_RELAXED, __HIP_MEMORY_SCOPE_AGENT); }
DI unsigned xb_add(unsigned* p, unsigned v) { return __hip_atomic_fetch_add(p, v, __ATOMIC_RELAXED, __HIP_MEMORY_SCOPE_AGENT); }
DI unsigned xb_xcc_id() { return (unsigned)__builtin_amdgcn_s_getreg((3 << 11) | 20) & 0xFu; }
#define XB_SPIN(cond, bar) do { unsigned _sp = 0; while (cond) { __builtin_amdgcn_s_sleep(1); \
    if ((++_sp & 255u) == 0u) { if (xb_ld(&(bar)[XB_TMO])) break; if (_sp > XB_SPIN_CAP) { atomicAdd(&(bar)[XB_TMO], 1u); break; } } } } while (0)
struct XcdBarrier { unsigned* bar; unsigned x; volatile LAS unsigned* st; };
DI XcdBarrier xcd_barrier_post(unsigned* bar, volatile LAS unsigned* st) {
  XcdBarrier b; b.bar = bar; b.x = xb_xcc_id(); b.st = st;
  if (threadIdx.x == 0) (void)xb_add(&bar[XB_XCNT(b.x)], 1u);
  return b;
}
DI void xcd_barrier_complete(unsigned* bar, unsigned x, unsigned& nloc, unsigned& nx) {
  const unsigned G = gridDim.x * gridDim.y * gridDim.z;
  unsigned sum, cnt, mine, sp = 0u;
  for (;;) {
    sum = 0u; cnt = 0u; mine = 0u;
#pragma unroll
    for (unsigned j = 0; j < 16; ++j) { const unsigned c = xb_ld(&bar[XB_XCNT(j)]); sum += c; cnt += (c > 0u) ? 1u : 0u; mine = (j == x) ? c : mine; }
    if (sum == G) break;
    __builtin_amdgcn_s_sleep(1);
    if ((++sp & 255u) == 0u) { if (xb_ld(&bar[XB_TMO])) break; if (sp > XB_SPIN_CAP) { atomicAdd(&bar[XB_TMO], 1u); break; } }
  }
  nloc = mine > 0u ? mine : 1u; nx = cnt > 0u ? cnt : 1u;
}
DI void xcd_barrier(const XcdBarrier& b) {
  asm volatile("s_waitcnt vmcnt(0)" ::: "memory");
  __syncthreads();
  if (threadIdx.x == 0) {
    unsigned* bar = b.bar;
    __builtin_amdgcn_s_waitcnt(0);
    unsigned nloc = b.st[0], nx = b.st[1];
    if (nloc == 0u) { xcd_barrier_complete(bar, b.x, nloc, nx); b.st[0] = nloc; b.st[1] = nx; }
    const unsigned old = xb_add(&bar[XB_XSUB(b.x)], 1u);
    const unsigned gen = old / nloc;
    if (old + 1u == (gen + 1u) * nloc) {
      __builtin_amdgcn_fence(__ATOMIC_RELEASE, "agent");
      asm volatile("s_waitcnt vmcnt(0)" ::: "memory");
      const unsigned og = xb_add(&bar[XB_TOP], 1u);
      const unsigned tg = og / nx;
      if (og + 1u == (tg + 1u) * nx) xb_add(&bar[XB_TOPGEN], 1u);
      else XB_SPIN(xb_ld(&bar[XB_TOPGEN]) == tg, bar);
      __builtin_amdgcn_fence(__ATOMIC_ACQUIRE, "agent");
      xb_add(&bar[XB_XGEN(b.x)], 1u);
      asm volatile("s_waitcnt vmcnt(0)" ::: "memory");
    } else {
      XB_SPIN(xb_ld(&bar[XB_XGEN(b.x)]) == gen, bar);
      __builtin_amdgcn_fence(__ATOMIC_ACQUIRE, "agent");
      asm volatile("s_waitcnt vmcnt(0)" ::: "memory");
    }
  }
  __syncthreads();
}

#define PROBE_DUP (-1)
constexpr int NPHASE = 1 + 14 + 13;
#define PROBE_REP_MASK 0
#define PROBE_REP_N 2
#define PROBE_XSYNC 0

__global__ void __launch_bounds__(256, 2) fwd_megakernel(Params p) {
  extern __shared__ __attribute__((aligned(16))) char lds[];
  cg::grid_group grid = cg::this_grid();
  volatile LAS unsigned* xbst = (volatile LAS unsigned*)(lds + LDS_BYTES - 16);
  if (threadIdx.x == 0) { xbst[0] = 0u; xbst[1] = 0u; }
  __syncthreads();
  XcdBarrier xb = xcd_barrier_post((unsigned*)(p.ws + OFF_BAR), xbst);
  for (int ph = p.ph_lo; ph < p.ph_hi; ++ph) {
    if (ph > p.ph_lo) {
      if (p.ph_lo < 0) grid.sync();
      xcd_barrier(xb);
      for (int xs = 0; xs < PROBE_XSYNC; ++xs) xcd_barrier(xb);
    }
#ifdef ONLY
    const int b = 0, q = ONLY; if (ONLY < 0) { phase_prep(p, lds, 0); continue; }
#else
    if (ph == 0) { phase_prep(p, lds, 0); continue; }
    const int idx = ph - 1;
    const int b = idx <= 13 ? 0 : 1, q = idx <= 13 ? idx : idx - 13;
    if (idx == 13) { phase_normmod(p, 1, 0); phase_prep(p, lds, 1); }
#endif
    for (int rep = 0; rep < ((PROBE_REP_MASK >> q) & 1 ? PROBE_REP_N : 1); ++rep)
    switch (q) {
      case 0: phase_normmod(p, b, 0); phase_prep(p, lds, 1); break;
      case 1: phase_gemm1(p, (hf*)lds); break;
      case 2: phase_stageA(p, (hf*)lds); break;
      case 3: phase_stageB(p, (hf*)lds); break;
      case 4: phase_group(p, (hf*)lds); break;
      case 5: phase_outproj(p, b, 0, (hf*)lds); break;
      case 6: phase_normmod(p, b, 1); break;
      case 7: phase_inproj1(p, (hf*)lds); break;
      case 8: phase_conv(p, lds); break;
      case 9: phase_dprep(p, lds); break;
      case 10: phase_scan(p, lds); break;
      case 11: phase_onorm(p); break;
      case 12: phase_outproj(p, b, 1, (hf*)lds); break;
      case 13: phase_final(p, b); break;
    }
  }
}

extern "C" void kernel_launch(void* const* d_in, const int* in_sizes, int n_in, void* d_out, int out_size, void* d_ws,
                              size_t ws_size, hipStream_t stream) {
  static int grid_blocks = 0;
  if (!grid_blocks) {
    int dev = 0, cus = 0, per_cu = 0;
    hipGetDevice(&dev);
    hipDeviceGetAttribute(&cus, hipDeviceAttributeMultiprocessorCount, dev);
    hipFuncSetAttribute((const void*)fwd_megakernel, hipFuncAttributeMaxDynamicSharedMemorySize, LDS_BYTES);
    hipOccupancyMaxActiveBlocksPerMultiprocessor(&per_cu, (const void*)fwd_megakernel, 256, LDS_BYTES);
    if (per_cu < 1) per_cu = 1;
    if (per_cu > 2) per_cu = 2;
    grid_blocks = cus * per_cu;
    if (ws_size < WS_NEED) fprintf(stderr, "workspace too small: %zu < %zu\n", ws_size, (size_t)WS_NEED);
  }
  Params p{};
  const float** f = (const float**)&p;
  for (int i = 0; i < 17; ++i) f[i] = (const float*)d_in[i];
  p.out = (float*)d_out;
  p.ws = (char*)d_ws;
  p.ph_lo = 0;
  p.ph_hi = NPHASE;
  void* args[] = {&p};
  (void)hipMemsetAsync((char*)d_ws + OFF_BAR, 0, XCD_BAR_WORDS * 4, stream);
  hipError_t e = hipLaunchCooperativeKernel((const void*)fwd_megakernel, dim3(grid_blocks), dim3(256), args, LDS_BYTES, stream);
  if (e != hipSuccess) fprintf(stderr, "cooperative launch failed: %s (grid %d)\n", hipGetErrorString(e), grid_blocks);
}
```
